# Optimizing an MI355X kernel written in HIP

```python
import math
import numpy as np
import jax
import jax.numpy as jnp
from jax import lax

D_MODEL = 1024
BATCH = 16
SEQ = 2048
DEPTH = 2

HEAD_DIM = 64
N_HEADS_TOTAL = D_MODEL // HEAD_DIM
N_HEADS_B = N_HEADS_TOTAL // 4
N_HEADS_C = (N_HEADS_TOTAL - N_HEADS_B) // 2
N_HEADS_A = N_HEADS_TOTAL - N_HEADS_B - N_HEADS_C
A_WIDTH = N_HEADS_A * HEAD_DIM
B_WIDTH = N_HEADS_B * HEAD_DIM
C_WIDTH = N_HEADS_C * HEAD_DIM
MIX_WIDTH = A_WIDTH + B_WIDTH + C_WIDTH
COL_SIZES = (3 * A_WIDTH, A_WIDTH, N_HEADS_A, N_HEADS_A,
             B_WIDTH, B_WIDTH, B_WIDTH, B_WIDTH,
             C_WIDTH, C_WIDTH, C_WIDTH, C_WIDTH)
IN_COLS = sum(COL_SIZES)
CONV_WIDTH = 4
GDN_CHUNK = 64
BLOCK = 128
ROPE_DIM = HEAD_DIM // 4
ROPE_THETA = 500000.0
DILATED_PAIRS = ((128, 1), (512, 4), (2048, 16))
RMS_EPS = 1e-6

kernel_name = "hybrid_gdn_stickbreak_dilated"


def rmsnorm(x, w):
    x32 = x.astype(jnp.float32)
    y = x32 * lax.rsqrt(jnp.mean(x32 * x32, axis=-1, keepdims=True) + RMS_EPS)
    return (y * w.astype(jnp.float32)).astype(x.dtype)


def l2norm(x):
    return x * lax.rsqrt(jnp.sum(x * x, axis=-1, keepdims=True) + RMS_EPS)


def causal_depthwise_conv(x, w):
    kw, ch = w.shape
    return lax.conv_general_dilated(
        x, w.astype(x.dtype)[:, None, :], window_strides=(1,),
        padding=((kw - 1, 0),), dimension_numbers=('NWC', 'WIO', 'NWC'),
        feature_group_count=ch)


def partial_rope(x, positions):
    half = ROPE_DIM // 2
    inv_freq = ROPE_THETA ** (-jnp.arange(half, dtype=jnp.float32) / half)
    ang = positions.astype(jnp.float32)[:, None] * inv_freq[None, :]
    cos = jnp.cos(ang)[None, :, None, :]
    sin = jnp.sin(ang)[None, :, None, :]
    x32 = x.astype(jnp.float32)
    x1 = x32[..., :half]
    x2 = x32[..., half:ROPE_DIM]
    out = jnp.concatenate([x1 * cos - x2 * sin, x2 * cos + x1 * sin, x32[..., ROPE_DIM:]], axis=-1)
    return out.astype(x.dtype)


def gated_delta_rule(q, k, v, g, beta):
    b, t, h, dk = q.shape
    dv = v.shape[-1]
    c = GDN_CHUNK
    n = t // c
    f32 = jnp.float32
    q = l2norm(q.astype(f32)) * (dk ** -0.5)
    k = l2norm(k.astype(f32))
    v = v.astype(f32)

    def chunk4(z):
        return z.reshape(b, n, c, h, z.shape[-1]).transpose(0, 1, 3, 2, 4)

    def chunk3(z):
        return z.astype(f32).reshape(b, n, c, h).transpose(0, 1, 3, 2)

    q, k, v = chunk4(q), chunk4(k), chunk4(v)
    g, beta = chunk3(g), chunk3(beta)
    gc = jnp.cumsum(g, axis=-1)
    idx = jnp.arange(c)
    incl = idx[:, None] >= idx[None, :]
    strict = idx[:, None] > idx[None, :]
    decay = jnp.exp(jnp.where(incl, gc[..., :, None] - gc[..., None, :], -jnp.inf))
    kb = k * beta[..., None]
    a = jnp.where(strict, jnp.einsum('bnhid,bnhjd->bnhij', kb, k) * decay, 0.0)
    eye = jnp.eye(c, dtype=f32)
    tmat = lax.linalg.triangular_solve(eye + a, jnp.broadcast_to(eye, a.shape),
                                       left_side=True, lower=True, unit_diagonal=True)
    u = tmat @ (v * beta[..., None])
    w = tmat @ (kb * jnp.exp(gc)[..., None])
    qk = jnp.einsum('bnhid,bnhjd->bnhij', q, k) * decay
    qg = q * jnp.exp(gc)[..., None]
    kg = k * jnp.exp(gc[..., -1:] - gc)[..., None]
    g_last = jnp.exp(gc[..., -1])

    def step(state, inp):
        qg_i, kg_i, u_i, w_i, qk_i, gl_i = inp
        v_new = u_i - w_i @ state
        o_i = qg_i @ state + qk_i @ v_new
        state = state * gl_i[..., None, None] + jnp.einsum('bhcd,bhce->bhde', kg_i, v_new)
        return state, o_i

    xs = tuple(jnp.moveaxis(z, 1, 0) for z in (qg, kg, u, w, qk, g_last))
    s0 = jnp.zeros((b, h, dk, dv), f32)
    _, o = lax.scan(step, s0, xs)
    return o.transpose(1, 0, 3, 2, 4).reshape(b, t, h, dv)


def stick_breaking_attention(q, k, v):
    b, t, h, dh = q.shape
    nb = t // BLOCK
    f32 = jnp.float32
    qb = (q.astype(f32) * (dh ** -0.5)).reshape(b, nb, BLOCK, h, dh).transpose(1, 0, 3, 2, 4)
    kt = k.astype(f32).transpose(0, 2, 1, 3)
    vt = v.astype(f32).transpose(0, 2, 1, 3)
    key_pos = jnp.arange(t)

    def one_block(args):
        q_blk, blk = args
        z = jnp.einsum('bhqd,bhkd->bhqk', q_blk, kt)
        q_pos = blk * BLOCK + jnp.arange(BLOCK)
        earlier = key_pos[None, :] < q_pos[:, None]
        log_beta = jnp.where(earlier, jax.nn.log_sigmoid(z), -jnp.inf)
        log_keep = jnp.where(earlier, jax.nn.log_sigmoid(-z), 0.0)
        log_keep_between = lax.cumsum(log_keep, axis=3, reverse=True) - log_keep
        wts = jnp.exp(log_beta + log_keep_between)
        return jnp.einsum('bhqk,bhkd->bhqd', wts, vt)

    o = lax.map(one_block, (qb, jnp.arange(nb)))
    return o.transpose(1, 0, 3, 2, 4).reshape(b, t, h, dh)


def dilated_window_attention(q, k, v, window, dilation):
    b, t, h, dh = q.shape
    steps = window // dilation
    length = t // dilation
    nb = -(-length // BLOCK)
    lp = nb * BLOCK
    f32 = jnp.float32

    def to_blocks(z):
        z = z.astype(f32).reshape(b, length, dilation, h, dh).transpose(0, 2, 3, 1, 4)
        z = jnp.pad(z, ((0, 0), (0, 0), (0, 0), (0, lp - length), (0, 0)))
        return z.reshape(b, dilation, h, nb, BLOCK, dh)

    def with_prev(z):
        prev = jnp.pad(z, ((0, 0), (0, 0), (0, 0), (1, 0), (0, 0), (0, 0)))[:, :, :, :-1]
        return jnp.concatenate([prev, z], axis=-2)

    qb = to_blocks(q) * (dh ** -0.5)
    kk = with_prev(to_blocks(k))
    vv = with_prev(to_blocks(v))
    s = jnp.einsum('brhnqe,brhnke->brhnqk', qb, kk)
    qi = jnp.arange(BLOCK)[:, None]
    kj = jnp.arange(2 * BLOCK)[None, :]
    rel = qi - kj + BLOCK
    key_idx = jnp.arange(nb)[:, None, None] * BLOCK + kj[None] - BLOCK
    mask = (rel >= 0) & (rel <= steps) & (key_idx >= 0)
    s = jnp.where(mask, s, -jnp.inf)
    m = jnp.max(s, axis=-1, keepdims=True)
    p = jnp.exp(s - m)
    denom = jnp.sum(p, axis=-1, keepdims=True)
    o = jnp.einsum('brhnqk,brhnke->brhnqe', p, vv) / denom
    lse = (m + jnp.log(denom))[..., 0]
    o = o.reshape(b, dilation, h, lp, dh)[:, :, :, :length].transpose(0, 3, 1, 2, 4).reshape(b, t, h, dh)
    lse = lse.reshape(b, dilation, h, lp)[..., :length].transpose(0, 3, 1, 2).reshape(b, t, h)
    return o, lse


def hybrid_layer(x, norm_w, w_in, conv_w, a_log, dt_bias, gdn_norm_w, q_norm_w, k_norm_w, w_out, positions):
    b, t, _ = x.shape
    f32 = jnp.float32
    hdn = rmsnorm(x, norm_w)
    proj = hdn @ w_in
    split_points = np.cumsum(COL_SIZES)[:-1].tolist()
    (qkv_a, z_a, beta_a, alpha_a, q_b, k_b, v_b, z_b,
     q_c, k_c, v_c, z_c) = jnp.split(proj, split_points, axis=-1)

    def heads(z, n_heads):
        return z.reshape(b, t, n_heads, HEAD_DIM)

    qkv_a = jax.nn.silu(causal_depthwise_conv(qkv_a, conv_w))
    q_a, k_a, v_a = jnp.split(qkv_a, 3, axis=-1)
    beta = jax.nn.sigmoid(beta_a.astype(f32))
    g = -jnp.exp(a_log.astype(f32)) * jax.nn.softplus(alpha_a.astype(f32) + dt_bias.astype(f32))
    o_a = gated_delta_rule(heads(q_a, N_HEADS_A), heads(k_a, N_HEADS_A), heads(v_a, N_HEADS_A), g, beta)
    o_a = rmsnorm(o_a, gdn_norm_w).reshape(b, t, A_WIDTH).astype(x.dtype) * jax.nn.silu(z_a)

    o_b = stick_breaking_attention(heads(q_b, N_HEADS_B), heads(k_b, N_HEADS_B), heads(v_b, N_HEADS_B))
    o_b = o_b.reshape(b, t, B_WIDTH).astype(x.dtype) * jax.nn.silu(z_b)

    qc = partial_rope(rmsnorm(heads(q_c, N_HEADS_C), q_norm_w), positions)
    kc = partial_rope(rmsnorm(heads(k_c, N_HEADS_C), k_norm_w), positions)
    vc = heads(v_c, N_HEADS_C)
    outs = []
    lses = []
    for window, dilation in DILATED_PAIRS:
        o_g, lse_g = dilated_window_attention(qc, kc, vc, window, dilation)
        outs.append(o_g)
        lses.append(lse_g)
    mix_w = jax.nn.softmax(jnp.stack(lses, axis=0), axis=0)
    o_c = jnp.einsum('gbth,gbthd->bthd', mix_w, jnp.stack(outs, axis=0))
    o_c = o_c.reshape(b, t, C_WIDTH).astype(x.dtype) * jax.nn.silu(z_c)

    mixed = jnp.concatenate([o_a, o_b, o_c], axis=-1)
    return x + mixed @ w_out


def setup_inputs(seed: int = 0) -> dict:
    key = jax.random.key(seed)
    ks = jax.random.split(key, 10)
    f32 = jnp.float32
    x = jax.random.normal(ks[0], (BATCH, SEQ, D_MODEL), f32)
    norm_w = 1.0 + 0.02 * jax.random.normal(ks[1], (DEPTH, D_MODEL), f32)
    w_in = jax.random.normal(ks[2], (DEPTH, D_MODEL, IN_COLS), f32) * (D_MODEL ** -0.5)
    conv_w = jax.random.normal(ks[3], (DEPTH, CONV_WIDTH, 3 * A_WIDTH), f32) * (CONV_WIDTH ** -0.5)
    a_log = jnp.log(jax.random.uniform(ks[4], (DEPTH, N_HEADS_A), f32, minval=1.0, maxval=16.0))
    dt = jnp.exp(jax.random.uniform(ks[5], (DEPTH, N_HEADS_A), f32,
                                    minval=math.log(1e-3), maxval=math.log(1e-1)))
    dt_bias = dt + jnp.log(-jnp.expm1(-dt))
    gdn_norm_w = 1.0 + 0.02 * jax.random.normal(ks[6], (DEPTH, HEAD_DIM), f32)
    q_norm_w = 1.0 + 0.02 * jax.random.normal(ks[7], (DEPTH, HEAD_DIM), f32)
    k_norm_w = 1.0 + 0.02 * jax.random.normal(ks[8], (DEPTH, HEAD_DIM), f32)
    w_out = jax.random.normal(ks[9], (DEPTH, MIX_WIDTH, D_MODEL), f32) * (MIX_WIDTH ** -0.5)
    return {"x": x, "norm_w": norm_w, "w_in": w_in, "conv_w": conv_w, "a_log": a_log,
            "dt_bias": dt_bias, "gdn_norm_w": gdn_norm_w, "q_norm_w": q_norm_w,
            "k_norm_w": k_norm_w, "w_out": w_out}


def reference(x, norm_w, w_in, conv_w, a_log, dt_bias, gdn_norm_w, q_norm_w, k_norm_w, w_out):
    positions = jnp.arange(x.shape[1], dtype=jnp.int32)
    for layer in range(DEPTH):
        x = hybrid_layer(x, norm_w[layer], w_in[layer], conv_w[layer], a_log[layer], dt_bias[layer],
                         gdn_norm_w[layer], q_norm_w[layer], k_norm_w[layer], w_out[layer], positions)
    return x
```

```cpp
#include <hip/hip_runtime.h>
#include <hip/hip_bf16.h>
#include <hip/hip_cooperative_groups.h>
#include <cstdio>
namespace cg = cooperative_groups;

typedef unsigned short u16;
using bf16x8 = __attribute__((ext_vector_type(8))) short;
using f32x4 = __attribute__((ext_vector_type(4))) float;
typedef __bf16 bf16x2_t __attribute__((ext_vector_type(2)));

#define DI __device__ __forceinline__

constexpr int NB = 16, SEQ = 2048, DM = 1024, NTOK = NB * SEQ;
constexpr int NP = 4096;
constexpr int NPAD = 4224;
constexpr int INC = 4108;
constexpr int MLD = NP;
constexpr int QA = 0, KA = 384, VA = 768, ZA = 1152, QB = 1536, KB = 1792, VB = 2048, ZB = 2304,
              QC = 2560, KC = 2944, VC = 3328, ZC = 3712;

#ifndef COOP
#define COOP 1
#endif
#define REP_IN 1
#define REP_MIX 1

struct Params {
  const float *x, *norm_w, *w_in, *conv_w, *a_log, *dt_bias, *gdn_norm_w, *q_norm_w, *k_norm_w, *w_out;
  float* out;
  u16 *WinT, *WoutT, *xb, *P, *mixed;
  float* BA;
  float *gU, *gGL, *ropeT;
  int* ctr;
  unsigned* bar;
  u16 *gW, *gQK, *gQG, *gKGt;
};

typedef float f32x2_t __attribute__((ext_vector_type(2)));
DI unsigned pk2(float lo, float hi) {
  const f32x2_t v = {lo, hi};
  return __builtin_bit_cast(unsigned, __builtin_convertvector(v, bf16x2_t));
}
DI u16 f2bf(float x) { return (u16)(pk2(x, 0.f) & 0xffffu); }
DI float bf2f(u16 h) { return __uint_as_float(((unsigned)h) << 16); }
DI float ex2(float x) { return __builtin_amdgcn_exp2f(x); }
DI float lg2(float x) { return __builtin_amdgcn_logf(x); }
DI float fexp(float x) { return ex2(x * 1.44269504088896f); }
DI float silu(float x) { return x * __builtin_amdgcn_rcpf(1.f + fexp(-x)); }
DI float softplus(float x) { return fmaxf(x, 0.f) + log1pf(expf(-fabsf(x))); }
DI float sigmoidf(float x) { return 1.f / (1.f + expf(-x)); }
DI int otid() { int t = threadIdx.x; asm volatile("" : "+v"(t)); return t; }
DI float wave_sum(float v) {
#pragma unroll
  for (int o = 32; o > 0; o >>= 1) v += __shfl_xor(v, o);
  return v;
}

DI int perm_col(int n) {
  if (n < 1536) return n;
  if (n < 4096) return n + 12;
  if (n < 4108) return 1536 + (n - 4096);
  return -1;
}

__device__ void phase_prep(const Params& p, float* smem, int bid, int nblk) {
  const int tid = otid();
  {
    const size_t n8 = (size_t)NTOK * DM / 8;
    for (size_t i = (size_t)bid * 256 + tid; i < n8; i += (size_t)nblk * 256) {
      const float4 a = ((const float4*)p.x)[2 * i], b = ((const float4*)p.x)[2 * i + 1];
      uint4 o;
      o.x = f2bf(a.x) | ((unsigned)f2bf(a.y) << 16);
      o.y = f2bf(a.z) | ((unsigned)f2bf(a.w) << 16);
      o.z = f2bf(b.x) | ((unsigned)f2bf(b.y) << 16);
      o.w = f2bf(b.z) | ((unsigned)f2bf(b.w) << 16);
      ((uint4*)p.xb)[i] = o;
    }
  }
  if (bid == 0 && tid < 8) p.ctr[tid] = 0;
  for (int i = bid * 256 + tid; i < SEQ * 8; i += nblk * 256) {
    const int t = i >> 3, f = i & 7;
    const float ang = (float)t * powf(500000.f, -(float)f / 8.f);
    p.ropeT[2 * i] = cosf(ang);
    p.ropeT[2 * i + 1] = sinf(ang);
  }
  const int nWin = 2 * (NPAD / 64) * 16, nWout = 2 * 16 * 16;
  float (*tile)[65] = (float (*)[65])smem;
  for (int u = bid; u < nWin + nWout; u += nblk) {
    const bool isin = u < nWin;
    int l, nt, kt;
    if (isin) { l = u / ((NPAD / 64) * 16); int r = u % ((NPAD / 64) * 16); nt = r / 16; kt = r % 16; }
    else { int v = u - nWin; l = v / 256; int r = v % 256; nt = r / 16; kt = r % 16; }
    const int tx = tid & 63, ty = tid >> 6;
    const int n = nt * 64 + tx;
    const int c = isin ? perm_col(n) : n;
    const float* src = isin ? p.w_in + (size_t)l * DM * INC : p.w_out + (size_t)l * DM * DM;
    const int ld = isin ? INC : DM;
    {
      const int cc = c >= 0 ? c : 0;
      const float msk = c >= 0 ? 1.f : 0.f;
      float wv[16], nwv[16];
#pragma unroll
      for (int i = 0; i < 16; ++i) {
        const int k = kt * 64 + ty + 4 * i;
        wv[i] = src[(size_t)k * ld + cc];
        nwv[i] = isin ? p.norm_w[l * DM + k] : 1.f;
      }
#pragma unroll
      for (int i = 0; i < 16; ++i) tile[ty + 4 * i][tx] = wv[i] * nwv[i] * msk;
    }
    __syncthreads();
    u16* dst = isin ? p.WinT + (size_t)l * NPAD * DM : p.WoutT + (size_t)l * DM * DM;
    for (int nn = ty; nn < 64; nn += 4)
      dst[(size_t)(nt * 64 + nn) * DM + kt * 64 + tx] = f2bf(tile[tx][nn]);
    __syncthreads();
  }
}

constexpr int LDT2 = 32;
template <int MODE>
__device__ void gemm_tile(const Params& p, const u16* __restrict__ A, const u16* __restrict__ Bt,
                          int mt, int nt, int layer, const float* resid, char* smem) {
  u16* sA = (u16*)smem;
  u16* sB = sA + 2 * 256 * LDT2;
  float* rs = (float*)(sB + 2 * 128 * LDT2);
  const int tid = otid(), lane = tid & 63, w = tid >> 6, wr = w >> 1, wc = w & 1;
  const int fr = lane & 15, fq = lane >> 4;
  const int lrow = tid >> 2, lch = tid & 3;
  const int wsw = lch ^ ((0x1320 >> (4 * ((lrow >> 2) & 3))) & 3);
  const int rsw = fq ^ ((0x1320 >> (4 * ((fr >> 2) & 3))) & 3);
  const size_t m0 = (size_t)mt * 256, n0 = (size_t)nt * 128;
  constexpr int K = DM, NK = K / 32;
  constexpr int LDA = MODE == 0 ? DM : MLD;
  f32x4 acc[8][4];
#pragma unroll
  for (int i = 0; i < 8; ++i)
#pragma unroll
    for (int j = 0; j < 4; ++j) acc[i][j] = f32x4{0.f, 0.f, 0.f, 0.f};
  float ss0 = 0.f, ss1 = 0.f, ss2 = 0.f, ss3 = 0.f;
  const char* bA = (const char*)(A + m0 * LDA);
  const char* bB = (const char*)(Bt + n0 * K);
  const unsigned vA = (unsigned)(lrow * LDA + lch * 8) * 2u;
  const unsigned vB = (unsigned)(lrow * K + lch * 8) * 2u;
#define G2_LOAD(S_, kt_)                                                 \
  {                                                                      \
    const unsigned ko_ = (unsigned)(kt_) * 64u;                          \
    S_##a0 = *(const uint4*)(bA + (vA + ko_));                           \
    S_##a1 = *(const uint4*)(bA + (size_t)64 * LDA * 2 + (vA + ko_));    \
    S_##a2 = *(const uint4*)(bA + (size_t)128 * LDA * 2 + (vA + ko_));   \
    S_##a3 = *(const uint4*)(bA + (size_t)192 * LDA * 2 + (vA + ko_));   \
    S_##b0 = *(const uint4*)(bB + (vB + ko_));                           \
    S_##b1 = *(const uint4*)(bB + (size_t)64 * K * 2 + (vB + ko_));      \
  }
#define G2_SSQ(acc_, v_)                                                                          \
  {                                                                                               \
    acc_ = __builtin_amdgcn_fdot2_f32_bf16(__builtin_bit_cast(bf16x2_t, v_.x), __builtin_bit_cast(bf16x2_t, v_.x), acc_, false); \
    acc_ = __builtin_amdgcn_fdot2_f32_bf16(__builtin_bit_cast(bf16x2_t, v_.y), __builtin_bit_cast(bf16x2_t, v_.y), acc_, false); \
    acc_ = __builtin_amdgcn_fdot2_f32_bf16(__builtin_bit_cast(bf16x2_t, v_.z), __builtin_bit_cast(bf16x2_t, v_.z), acc_, false); \
    acc_ = __builtin_amdgcn_fdot2_f32_bf16(__builtin_bit_cast(bf16x2_t, v_.w), __builtin_bit_cast(bf16x2_t, v_.w), acc_, false); \
  }
#define G2_STASH(S_, buf_)                                               \
  {                                                                      \
    u16* dA_ = sA + ((buf_) * 256 + lrow) * LDT2 + wsw * 8;              \
    u16* dB_ = sB + ((buf_) * 128 + lrow) * LDT2 + wsw * 8;              \
    *(uint4*)(dA_) = S_##a0;                                             \
    *(uint4*)(dA_ + 64 * LDT2) = S_##a1;                                 \
    *(uint4*)(dA_ + 128 * LDT2) = S_##a2;                                \
    *(uint4*)(dA_ + 192 * LDT2) = S_##a3;                                \
    *(uint4*)(dB_) = S_##b0;                                             \
    *(uint4*)(dB_ + 64 * LDT2) = S_##b1;                                 \
    if (MODE == 0) { G2_SSQ(ss0, S_##a0) G2_SSQ(ss1, S_##a1) G2_SSQ(ss2, S_##a2) G2_SSQ(ss3, S_##a3) } \
  }
#define G2_COMPUTE(cur_)                                                                                   \
  {                                                                                                        \
    bf16x8 bfr[4];                                                                                         \
    _Pragma("unroll") for (int n = 0; n < 4; ++n)                                                          \
      bfr[n] = *(const bf16x8*)(sB + ((cur_) * 128 + wc * 64 + n * 16 + fr) * LDT2 + rsw * 8);             \
    _Pragma("unroll") for (int hm = 0; hm < 2; ++hm) {                                                     \
      bf16x8 af[4];                                                                                        \
      _Pragma("unroll") for (int m = 0; m < 4; ++m)                                                        \
        af[m] = *(const bf16x8*)(sA + ((cur_) * 256 + wr * 128 + (hm * 4 + m) * 16 + fr) * LDT2 + rsw * 8); \
      _Pragma("unroll") for (int m = 0; m < 4; ++m)                                                        \
        _Pragma("unroll") for (int n = 0; n < 4; ++n)                                                      \
          acc[hm * 4 + m][n] = __builtin_amdgcn_mfma_f32_16x16x32_bf16(af[m], bfr[n], acc[hm * 4 + m][n], 0, 0, 0); \
    }                                                                                                      \
  }
  uint4 Xa0, Xa1, Xa2, Xa3, Xb0, Xb1, Ya0, Ya1, Ya2, Ya3, Yb0, Yb1;
  __syncthreads();
  G2_LOAD(X, 0);
  G2_LOAD(Y, 1);
  G2_STASH(X, 0);
  __syncthreads();
  for (int kt = 0; kt < NK; kt += 2) {
    { const int k2 = kt + 2 < NK ? kt + 2 : NK - 1; G2_LOAD(X, k2); }
    G2_COMPUTE(0);
    G2_STASH(Y, 1);
    __syncthreads();
    { const int k3 = kt + 3 < NK ? kt + 3 : NK - 1; G2_LOAD(Y, k3); }
    G2_COMPUTE(1);
    if (kt + 2 < NK) G2_STASH(X, 0);
    __syncthreads();
  }
#undef G2_LOAD
#undef G2_STASH
#undef G2_COMPUTE
#undef G2_SSQ
  if (MODE == 0) {
    {
      float s0 = ss0, s1 = ss1, s2 = ss2, s3 = ss3;
      s0 += __shfl_xor(s0, 1); s0 += __shfl_xor(s0, 2);
      s1 += __shfl_xor(s1, 1); s1 += __shfl_xor(s1, 2);
      s2 += __shfl_xor(s2, 1); s2 += __shfl_xor(s2, 2);
      s3 += __shfl_xor(s3, 1); s3 += __shfl_xor(s3, 2);
      if (lch == 0) {
        rs[lrow] = rsqrtf(s0 * (1.f / DM) + 1e-6f);
        rs[lrow + 64] = rsqrtf(s1 * (1.f / DM) + 1e-6f);
        rs[lrow + 128] = rsqrtf(s2 * (1.f / DM) + 1e-6f);
        rs[lrow + 192] = rsqrtf(s3 * (1.f / DM) + 1e-6f);
      }
    }
    __syncthreads();
    const bool isqk = false;
    if (isqk) {
      const float* nwp = (nt >= 23 ? p.k_norm_w : p.q_norm_w) + layer * 64;
      float nwv[4];
#pragma unroll
      for (int n = 0; n < 4; ++n) nwv[n] = nwp[16 * n + fr];
#pragma unroll
      for (int m = 0; m < 8; ++m)
#pragma unroll
        for (int j = 0; j < 4; ++j) {
          const int row = wr * 128 + m * 16 + fq * 4 + j;
          const float r = rs[row];
          float v[4];
          float sq = 0.f;
#pragma unroll
          for (int n = 0; n < 4; ++n) { v[n] = acc[m][n][j] * r; sq += v[n] * v[n]; }
          sq += __shfl_xor(sq, 1); sq += __shfl_xor(sq, 2); sq += __shfl_xor(sq, 4); sq += __shfl_xor(sq, 8);
          const float rr = rsqrtf(sq * (1.f / 64.f) + 1e-6f);
#pragma unroll
          for (int n = 0; n < 4; ++n) v[n] = v[n] * rr * nwv[n];
          const float partner = __shfl_xor(v[0], 8);
          const int t = (int)((m0 + row) & (SEQ - 1));
          const float2 cssn = *(const float2*)(p.ropeT + ((size_t)t * 8 + (fr & 7)) * 2);
          v[0] = fr < 8 ? v[0] * cssn.x - partner * cssn.y : v[0] * cssn.x + partner * cssn.y;
#pragma unroll
          for (int n = 0; n < 4; ++n) p.P[(m0 + row) * NP + n0 + wc * 64 + n * 16 + fr] = f2bf(v[n]);
        }
    } else {
#pragma unroll
      for (int m = 0; m < 8; ++m)
#pragma unroll
        for (int j = 0; j < 4; ++j) {
          const int row = wr * 128 + m * 16 + fq * 4 + j;
          const float r = rs[row];
#pragma unroll
          for (int n = 0; n < 4; ++n) {
            const int col = wc * 64 + n * 16 + fr;
            const float v = acc[m][n][j] * r;
            if (nt < 32) p.P[(m0 + row) * NP + n0 + col] = f2bf(v);
            else if (col < 16) p.BA[(m0 + row) * 16 + col] = v;
          }
        }
    }
  } else {
#pragma unroll
    for (int m = 0; m < 8; ++m) {
      float rv[16];
#pragma unroll
      for (int j = 0; j < 4; ++j)
#pragma unroll
        for (int n = 0; n < 4; ++n) {
          const float* ptr_ = resid + (m0 + wr * 128 + m * 16 + fq * 4 + j) * DM + n0 + wc * 64 + n * 16 + fr;
          asm volatile("global_load_dword %0, %1, off" : "=v"(rv[j * 4 + n]) : "v"(ptr_) : "memory");
        }
      asm volatile("s_waitcnt vmcnt(0)"
                   : "+v"(rv[0]), "+v"(rv[1]), "+v"(rv[2]), "+v"(rv[3]), "+v"(rv[4]), "+v"(rv[5]), "+v"(rv[6]), "+v"(rv[7]),
                     "+v"(rv[8]), "+v"(rv[9]), "+v"(rv[10]), "+v"(rv[11]), "+v"(rv[12]), "+v"(rv[13]), "+v"(rv[14]), "+v"(rv[15])
                   :: "memory");
#pragma unroll
      for (int j = 0; j < 4; ++j)
#pragma unroll
        for (int n = 0; n < 4; ++n) {
          const size_t o = (m0 + wr * 128 + m * 16 + fq * 4 + j) * DM + n0 + wc * 64 + n * 16 + fr;
          rv[j * 4 + n] += acc[m][n][j];
          p.out[o] = rv[j * 4 + n];
        }
      if (layer == 0) {
#pragma unroll
        for (int j = 0; j < 4; ++j)
#pragma unroll
          for (int n = 0; n < 4; ++n)
            p.xb[(m0 + wr * 128 + m * 16 + fq * 4 + j) * DM + n0 + wc * 64 + n * 16 + fr] = f2bf(rv[j * 4 + n]);
      }
    }
  }
}

__device__ void phase_inproj(const Params& p, int layer, char* smem, int bid, int nblk) {
  const u16* Bt = p.WinT + (size_t)layer * NPAD * DM;
  const bool aff = (nblk & 7) == 0;
  const int x = bid & 7, slot = bid >> 3, nslot = nblk >> 3;
  const int start = aff ? slot : bid, step = aff ? nslot : nblk, total = aff ? 16 * 33 : 128 * 33;
  for (int j = start; j < total; j += step) {
    int mt, nt;
    if (aff) { const int g = j / 264, r = j % 264; mt = x * 16 + g * 8 + (r & 7); nt = r >> 3; }
    else { mt = j / 33; nt = j % 33; }
    gemm_tile<0>(p, p.xb, Bt, mt, nt, layer, nullptr, smem);
  }
}
__device__ void phase_outproj(const Params& p, int layer, char* smem, int bid, int nblk) {
  const float* resid = layer == 0 ? p.x : p.out;
  const u16* Bt = p.WoutT + (size_t)layer * DM * DM;
  const bool aff = (nblk & 7) == 0;
  const int x = bid & 7, slot = bid >> 3, nslot = nblk >> 3;
  const int start = aff ? slot : bid, step = aff ? nslot : nblk, total = aff ? 16 * 8 : 128 * 8;
  for (int j = start; j < total; j += step) {
    const int mt = aff ? x * 16 + (j >> 3) : j >> 3, nt = j & 7;
    gemm_tile<1>(p, p.mixed, Bt, mt, nt, layer, resid, smem);
  }
}

__device__ void gdn_prep(const Params& p, int layer, int ci, char* smem);
__device__ void phase_qknorm(const Params& p, int layer, char* smem, int bid, int nblk) {
  {
    const size_t nl = (size_t)NTOK * 96;
    for (size_t L = (size_t)bid * 256 + otid(); L < nl; L += (size_t)nblk * 256) {
      const int tok = (int)(L / 96), rem = (int)(L % 96), r = rem >> 3, sub = rem & 7;
      const int isk = r >= 6, t = tok & (SEQ - 1);
      u16* ptr = p.P + (size_t)tok * NP + QC + rem * 8;
      const float* nw = (isk ? p.k_norm_w : p.q_norm_w) + layer * 64 + sub * 8;
      const uint4 raw = *(const uint4*)ptr;
      float v[8];
      v[0] = __uint_as_float(raw.x << 16); v[1] = __uint_as_float(raw.x & 0xffff0000u);
      v[2] = __uint_as_float(raw.y << 16); v[3] = __uint_as_float(raw.y & 0xffff0000u);
      v[4] = __uint_as_float(raw.z << 16); v[5] = __uint_as_float(raw.z & 0xffff0000u);
      v[6] = __uint_as_float(raw.w << 16); v[7] = __uint_as_float(raw.w & 0xffff0000u);
      float ssq = 0.f;
#pragma unroll
      for (int e = 0; e < 8; ++e) ssq += v[e] * v[e];
      ssq += __shfl_xor(ssq, 1); ssq += __shfl_xor(ssq, 2); ssq += __shfl_xor(ssq, 4);
      const float rr = rsqrtf(ssq * (1.f / 64.f) + 1e-6f);
#pragma unroll
      for (int e = 0; e < 8; ++e) v[e] = v[e] * rr * nw[e];
      float pv[8];
#pragma unroll
      for (int e = 0; e < 8; ++e) pv[e] = __shfl_xor(v[e], 1);
      if (sub < 2) {
        const float4* rt = (const float4*)(p.ropeT + (size_t)t * 16);
        const float4 c0 = rt[0], c1 = rt[1], c2 = rt[2], c3 = rt[3];
        const float cs[8] = {c0.x, c0.z, c1.x, c1.z, c2.x, c2.z, c3.x, c3.z};
        const float sn[8] = {c0.y, c0.w, c1.y, c1.w, c2.y, c2.w, c3.y, c3.w};
#pragma unroll
        for (int e = 0; e < 8; ++e) v[e] = sub == 0 ? v[e] * cs[e] - pv[e] * sn[e] : v[e] * cs[e] + pv[e] * sn[e];
      }
      uint4 o;
      o.x = pk2(v[0], v[1]); o.y = pk2(v[2], v[3]); o.z = pk2(v[4], v[5]); o.w = pk2(v[6], v[7]);
      *(uint4*)ptr = o;
    }
  }
  for (int u = bid; u < 96 * 32; u += nblk) gdn_prep(p, layer, u, smem);
}

DI bf16x8 packB(const f32x4& a, const f32x4& b) {
  typedef unsigned u32x4 __attribute__((ext_vector_type(4)));
  u32x4 r;
  r[0] = pk2(a[0], a[1]); r[1] = pk2(a[2], a[3]); r[2] = pk2(b[0], b[1]); r[3] = pk2(b[2], b[3]);
  return __builtin_bit_cast(bf16x8, r);
}
DI bf16x8 ldfragP(const u16* X, int ld, int row, int ks, int fq) {
  typedef unsigned u32x4 __attribute__((ext_vector_type(4)));
  const u16* r = X + (size_t)row * ld + 32 * ks + 4 * fq;
  const uint2 lo = *(const uint2*)r, hi = *(const uint2*)(r + 16);
  u32x4 v; v[0] = lo.x; v[1] = lo.y; v[2] = hi.x; v[3] = hi.y;
  return __builtin_bit_cast(bf16x8, v);
}

__device__ void gdn_prep(const Params& p, int layer, int ci, char* smem) {
  float* Kf = (float*)smem;
  float* Vf = Kf + 64 * 65;
  float* Am = Vf + 64 * 65;
  u16* Qs = (u16*)(Am + 64 * 68);
  u16* Ks = Qs + 64 * 72;
  float* gcs = (float*)(Ks + 64 * 72);
  float* bts = gcs + 64;
  float* rsc = bts + 64;
  const int tid = otid(), lane = tid & 63, w = tid >> 6;
  const int n = ci & 31, bh = ci >> 5, b = bh / 6, h = bh % 6;
  const size_t tok0 = (size_t)b * SEQ + n * 64;
  const size_t cb = (size_t)ci * 4096;
  if (w == 0) {
    const size_t tok = tok0 + lane;
    const float beta = sigmoidf(p.BA[tok * 16 + h]);
    const float g = -expf(p.a_log[layer * 6 + h]) * softplus(p.BA[tok * 16 + 6 + h] + p.dt_bias[layer * 6 + h]);
    float c = g;
#pragma unroll
    for (int o = 1; o < 64; o <<= 1) { const float t = __shfl_up(c, o); if (lane >= o) c += t; }
    gcs[lane] = c; bts[lane] = beta; rsc[lane] = beta * expf(c);
  }
  __syncthreads();
  {
    const float* cw = p.conv_w + (size_t)layer * 4 * 1152;
    unsigned rw0[19], rw1[19], rw2[19];
#define CONV_ISSUE(dst_, sec_)                                                                        \
    _Pragma("unroll") for (int j = 0; j < 19; ++j) {                                                  \
      const int tl_ = n * 64 + w * 16 + j - 3;                                                        \
      const u16* ptr_ = p.P + ((size_t)b * SEQ + (tl_ >= 0 ? tl_ : 0)) * NP + (sec_) * 384 + h * 64 + lane; \
      asm volatile("global_load_ushort %0, %1, off" : "=v"(dst_[j]) : "v"(ptr_) : "memory");          \
    }
#define CONV_WAIT(d_)                                                                                 \
    asm volatile("s_waitcnt vmcnt(0)"                                                                 \
                 : "+v"(d_[0]), "+v"(d_[1]), "+v"(d_[2]), "+v"(d_[3]), "+v"(d_[4]), "+v"(d_[5]), "+v"(d_[6]),      \
                   "+v"(d_[7]), "+v"(d_[8]), "+v"(d_[9]), "+v"(d_[10]), "+v"(d_[11]), "+v"(d_[12]), "+v"(d_[13]),  \
                   "+v"(d_[14]), "+v"(d_[15]), "+v"(d_[16]), "+v"(d_[17]), "+v"(d_[18]) :: "memory");
    CONV_ISSUE(rw0, 0)
    CONV_ISSUE(rw1, 1)
    CONV_ISSUE(rw2, 2)
    CONV_WAIT(rw0)
    CONV_WAIT(rw1)
    CONV_WAIT(rw2)
#undef CONV_ISSUE
#undef CONV_WAIT
#pragma unroll
    for (int sec = 0; sec < 3; ++sec) {
      const int col = sec * 384 + h * 64 + lane;
      float wt[4];
#pragma unroll
      for (int j = 0; j < 4; ++j) wt[j] = cw[j * 1152 + col];
      float xr[19];
#pragma unroll
      for (int j = 0; j < 19; ++j) {
        const int tl = n * 64 + w * 16 + j - 3;
        const unsigned rv = sec == 0 ? rw0[j] : (sec == 1 ? rw1[j] : rw2[j]);
        xr[j] = tl >= 0 ? __uint_as_float(rv << 16) : 0.f;
      }
      float* dst = sec == 0 ? Am : (sec == 1 ? Kf : Vf);
      const int dld = sec == 0 ? 68 : 65;
#pragma unroll
      for (int i = 0; i < 16; ++i) {
        float v = wt[0] * xr[i] + wt[1] * xr[i + 1] + wt[2] * xr[i + 2] + wt[3] * xr[i + 3];
        dst[(w * 16 + i) * dld + lane] = silu(v);
      }
    }
  }
  __syncthreads();
  {
    const int ti = tid >> 2, qd = tid & 3;
    float qv[16], kv[16];
    float sq = 0.f, sk = 0.f;
#pragma unroll
    for (int e = 0; e < 16; ++e) {
      qv[e] = Am[ti * 68 + qd * 16 + e]; kv[e] = Kf[ti * 65 + qd * 16 + e];
      sq += qv[e] * qv[e]; sk += kv[e] * kv[e];
    }
    sq += __shfl_xor(sq, 1); sq += __shfl_xor(sq, 2);
    sk += __shfl_xor(sk, 1); sk += __shfl_xor(sk, 2);
    const float rq = rsqrtf(sq + 1e-6f) * 0.125f, rk = rsqrtf(sk + 1e-6f);
    const float eg = fexp(gcs[ti]);
    unsigned qg[8];
#pragma unroll
    for (int e = 0; e < 16; e += 2) {
      const float q0 = qv[e] * rq, q1 = qv[e + 1] * rq, k0 = kv[e] * rk, k1 = kv[e + 1] * rk;
      *(unsigned*)(Qs + ti * 72 + qd * 16 + e) = pk2(q0, q1);
      *(unsigned*)(Ks + ti * 72 + qd * 16 + e) = pk2(k0, k1);
      Kf[ti * 65 + qd * 16 + e] = k0; Kf[ti * 65 + qd * 16 + e + 1] = k1;
      qg[e >> 1] = pk2(q0 * eg, q1 * eg);
    }
    uint4* gq = (uint4*)(p.gQG + cb + ti * 64 + qd * 16);
    gq[0] = make_uint4(qg[0], qg[1], qg[2], qg[3]);
    gq[1] = make_uint4(qg[4], qg[5], qg[6], qg[7]);
  }
  __syncthreads();
  {
    const int fr = lane & 15, fq = lane >> 4;
    bf16x8 ak[2], aq[2];
#pragma unroll
    for (int ks = 0; ks < 2; ++ks) {
      ak[ks] = *(const bf16x8*)(Ks + (16 * w + fr) * 72 + ks * 32 + fq * 8);
      aq[ks] = *(const bf16x8*)(Qs + (16 * w + fr) * 72 + ks * 32 + fq * 8);
    }
#pragma unroll
    for (int nn = 0; nn < 4; ++nn) {
      f32x4 cA = {0.f, 0.f, 0.f, 0.f}, cQ = {0.f, 0.f, 0.f, 0.f};
#pragma unroll
      for (int ks = 0; ks < 2; ++ks) {
        const bf16x8 bk = *(const bf16x8*)(Ks + (16 * nn + fr) * 72 + ks * 32 + fq * 8);
        cA = __builtin_amdgcn_mfma_f32_16x16x32_bf16(ak[ks], bk, cA, 0, 0, 0);
        cQ = __builtin_amdgcn_mfma_f32_16x16x32_bf16(aq[ks], bk, cQ, 0, 0, 0);
      }
#pragma unroll
      for (int j = 0; j < 4; ++j) {
        const int i = 16 * w + 4 * fq + j, jj = 16 * nn + fr;
        const float dec = (i >= jj) ? fexp(gcs[i] - gcs[jj]) : 0.f;
        Am[i * 68 + jj] = (i > jj) ? bts[i] * cA[j] * dec : 0.f;
        p.gQK[cb + i * 64 + jj] = f2bf(cQ[j] * dec);
      }
    }
  }
  __syncthreads();
  if (tid < 128) {
    const int c = tid & 63;
    const bool isw = tid >= 64;
    const float* X = isw ? Kf : Vf;
    const float* sc = isw ? rsc : bts;
    float x[64];
#pragma unroll
    for (int i = 0; i < 64; ++i) {
      float acc = sc[i] * X[i * 65 + c];
#pragma unroll
      for (int j = 0; j < i; ++j) acc -= Am[i * 68 + j] * x[j];
      x[i] = acc;
      if (isw) p.gW[cb + i * 64 + c] = f2bf(-acc);
      else p.gU[cb + i * 64 + c] = acc;
      asm volatile("" ::: "memory");
    }
  } else {
    const float e = fexp(gcs[63] - gcs[lane]);
    for (int d = 0; d < 32; ++d) {
      const int dk = (w - 2) * 32 + d;
      p.gKGt[cb + dk * 64 + lane] = f2bf(Kf[lane * 65 + dk] * e);
    }
    if (tid == 128) p.gGL[ci] = expf(gcs[63]);
  }
  __syncthreads();
}

__device__ void gdn_rec(const Params& p, int layer, int bh, char* smem) {
  u16* sM = (u16*)smem;
  u16* sZ = sM + 4 * 64 * 72;
  float* part = (float*)(sZ + 64 * 72);
  const int tid = otid(), lane = tid & 63, w = tid >> 6, fr = lane & 15, fq = lane >> 4;
  const int b = bh / 6, h = bh % 6;
  f32x4 S[4];
#pragma unroll
  for (int m = 0; m < 4; ++m) S[m] = f32x4{0.f, 0.f, 0.f, 0.f};
  const float gw = p.gdn_norm_w[layer * 64 + 16 * w + fr];
  const int srow = tid >> 3, sch = tid & 7;
  uint4 A0, A1, A2, A3, A4, A5, A6, A7, A8, A9, B0, B1, B2, B3, B4, B5, B6, B7, B8, B9;
  f32x4 Au[4], Bu[4], uc[4];
  float Agl, Bgl, glc;
#define GDN_LOAD(S_, nn_)                                                                     \
  {                                                                                           \
    const size_t cb_ = ((size_t)bh * 32 + (nn_)) * 4096;                                      \
    const size_t o0_ = cb_ + srow * 64 + sch * 8, o1_ = o0_ + 32 * 64;                        \
    S_##0 = *(const uint4*)(p.gW + o0_);   S_##1 = *(const uint4*)(p.gW + o1_);               \
    S_##2 = *(const uint4*)(p.gQG + o0_);  S_##3 = *(const uint4*)(p.gQG + o1_);              \
    S_##4 = *(const uint4*)(p.gQK + o0_);  S_##5 = *(const uint4*)(p.gQK + o1_);              \
    S_##6 = *(const uint4*)(p.gKGt + o0_); S_##7 = *(const uint4*)(p.gKGt + o1_);             \
    const u16* zp_ = p.P + ((size_t)b * SEQ + (nn_) * 64 + srow) * NP + ZA + h * 64 + sch * 8; \
    S_##8 = *(const uint4*)(zp_);          S_##9 = *(const uint4*)(zp_ + (size_t)32 * NP);    \
    _Pragma("unroll") for (int m = 0; m < 4; ++m)                                             \
      _Pragma("unroll") for (int j = 0; j < 4; ++j)                                           \
        S_##u[m][j] = p.gU[cb_ + (16 * m + 4 * fq + j) * 64 + 16 * w + fr];                   \
    S_##gl = p.gGL[bh * 32 + (nn_)];                                                          \
  }
#define GDN_STASH(S_)                                                                         \
  {                                                                                           \
    u16* d0_ = sM + srow * 72 + sch * 8;                                                      \
    u16* d1_ = d0_ + 32 * 72;                                                                 \
    *(uint4*)(d0_) = S_##0;               *(uint4*)(d1_) = S_##1;                             \
    *(uint4*)(d0_ + 64 * 72) = S_##2;     *(uint4*)(d1_ + 64 * 72) = S_##3;                   \
    *(uint4*)(d0_ + 2 * 64 * 72) = S_##4; *(uint4*)(d1_ + 2 * 64 * 72) = S_##5;               \
    *(uint4*)(d0_ + 3 * 64 * 72) = S_##6; *(uint4*)(d1_ + 3 * 64 * 72) = S_##7;               \
    *(uint4*)(d0_ + 4 * 64 * 72) = S_##8; *(uint4*)(d1_ + 4 * 64 * 72) = S_##9;               \
    _Pragma("unroll") for (int m = 0; m < 4; ++m) uc[m] = S_##u[m];                           \
    glc = S_##gl;                                                                             \
  }
#define GDN_BODY(n_, NEXT_)                                                                   \
  {                                                                                           \
    bf16x8 Sb[2], Vb[2];                                                                      \
    Sb[0] = packB(S[0], S[1]);                                                                \
    Sb[1] = packB(S[2], S[3]);                                                                \
    f32x4 av[4];                                                                              \
    _Pragma("unroll") for (int m = 0; m < 4; ++m) {                                           \
      av[m] = uc[m];                                                                          \
      _Pragma("unroll") for (int ks = 0; ks < 2; ++ks)                                        \
        av[m] = __builtin_amdgcn_mfma_f32_16x16x32_bf16(ldfragP(sM, 72, 16 * m + fr, ks, fq), Sb[ks], av[m], 0, 0, 0); \
    }                                                                                         \
    Vb[0] = packB(av[0], av[1]);                                                              \
    Vb[1] = packB(av[2], av[3]);                                                              \
    f32x4 O[4];                                                                               \
    _Pragma("unroll") for (int m = 0; m < 4; ++m) {                                           \
      f32x4 o = {0.f, 0.f, 0.f, 0.f};                                                         \
      _Pragma("unroll") for (int ks = 0; ks < 2; ++ks) {                                      \
        o = __builtin_amdgcn_mfma_f32_16x16x32_bf16(ldfragP(sM + 64 * 72, 72, 16 * m + fr, ks, fq), Sb[ks], o, 0, 0, 0);     \
        o = __builtin_amdgcn_mfma_f32_16x16x32_bf16(ldfragP(sM + 2 * 64 * 72, 72, 16 * m + fr, ks, fq), Vb[ks], o, 0, 0, 0); \
      }                                                                                       \
      O[m] = o;                                                                               \
    }                                                                                         \
    _Pragma("unroll") for (int m = 0; m < 4; ++m) {                                           \
      f32x4 sacc = S[m] * glc;                                                                \
      _Pragma("unroll") for (int ks = 0; ks < 2; ++ks)                                        \
        sacc = __builtin_amdgcn_mfma_f32_16x16x32_bf16(ldfragP(sM + 3 * 64 * 72, 72, 16 * m + fr, ks, fq), Vb[ks], sacc, 0, 0, 0); \
      S[m] = sacc;                                                                            \
    }                                                                                         \
    f32x4 zc[4];                                                                              \
    _Pragma("unroll") for (int m = 0; m < 4; ++m)                                             \
      _Pragma("unroll") for (int j = 0; j < 4; ++j)                                           \
        zc[m][j] = bf2f(sZ[(16 * m + 4 * fq + j) * 72 + 16 * w + fr]);                        \
    _Pragma("unroll") for (int hh = 0; hh < 2; ++hh) {                                        \
      f32x4 sq0 = O[2 * hh] * O[2 * hh], sq1 = O[2 * hh + 1] * O[2 * hh + 1];                 \
      _Pragma("unroll") for (int msk = 1; msk < 16; msk <<= 1) {                              \
        _Pragma("unroll") for (int j = 0; j < 4; ++j) {                                       \
          sq0[j] += __shfl_xor(sq0[j], msk); sq1[j] += __shfl_xor(sq1[j], msk);               \
        }                                                                                     \
      }                                                                                       \
      if (fr == 0) {                                                                          \
        *(f32x4*)(part + w * 64 + 16 * (2 * hh) + 4 * fq) = sq0;                              \
        *(f32x4*)(part + w * 64 + 16 * (2 * hh + 1) + 4 * fq) = sq1;                          \
      }                                                                                       \
    }                                                                                         \
    __syncthreads();                                                                          \
    GDN_STASH(NEXT_);                                                                         \
    _Pragma("unroll") for (int m = 0; m < 4; ++m)                                             \
      _Pragma("unroll") for (int j = 0; j < 4; ++j) {                                         \
        const int row = 16 * m + 4 * fq + j;                                                  \
        const float tot = (part[row] + part[64 + row]) + (part[128 + row] + part[192 + row]); \
        const float rr = rsqrtf(tot * (1.f / 64.f) + 1e-6f);                                  \
        const size_t tok = (size_t)b * SEQ + (n_) * 64 + row;                                 \
        const int col = h * 64 + 16 * w + fr;                                                 \
        p.mixed[tok * MLD + col] = f2bf(O[m][j] * rr * gw * silu(zc[m][j]));                  \
      }                                                                                       \
    __syncthreads();                                                                          \
  }
  __syncthreads();
  __builtin_amdgcn_s_setprio(3);
  GDN_LOAD(A, 0);
  GDN_LOAD(B, 1);
  GDN_STASH(A);
  __syncthreads();
  for (int n = 0; n < 32; n += 2) {
    { const int n2 = n + 2 < 32 ? n + 2 : 31; GDN_LOAD(A, n2); }
    GDN_BODY(n, B);
    { const int n3 = n + 3 < 32 ? n + 3 : 31; GDN_LOAD(B, n3); }
    GDN_BODY(n + 1, A);
  }
  __builtin_amdgcn_s_setprio(0);
#undef GDN_LOAD
#undef GDN_STASH
#undef GDN_BODY
}

typedef short s16x4 __attribute__((ext_vector_type(4)));
DI s16x4 tr_read(const u16* lds_ptr) {
  return __builtin_amdgcn_ds_read_tr16_b64_v4i16((__attribute__((address_space(3))) s16x4*)(lds_ptr));
}
DI bf16x8 vt_frag(const u16* sV, int key0, int mm, int lane) {
  const int fq = lane >> 4, q = (lane & 15) >> 2, pp = lane & 3;
  const u16* a = sV + (key0 + 4 * fq + q) * 72 + 16 * mm + 4 * pp;
  const s16x4 lo = tr_read(a), hi = tr_read(a + 16 * 72);
  return __builtin_shufflevector(lo, hi, 0, 1, 2, 3, 4, 5, 6, 7);
}

__device__ void sb_mfma(const Params& p, int unit, char* smem) {
  u16* sK = (u16*)smem;
  u16* sV = sK + 2 * 64 * 72;
  const int tid = otid(), lane = tid & 63, w = tid >> 6, fr = lane & 15, fq = lane >> 4;
  const int bh = unit & 63, qb = 31 - (unit >> 6), b = bh >> 2, h = bh & 3;
  const int t0 = qb * 64;
  const int tq = t0 + 16 * w + fr;
  const size_t tokq = (size_t)b * SEQ + tq;
  bf16x8 qf[2];
#pragma unroll
  for (int ks = 0; ks < 2; ++ks) qf[ks] = *(const bf16x8*)(p.P + tokq * NP + QB + h * 64 + 32 * ks + 8 * fq);
  f32x4 ot[4];
#pragma unroll
  for (int mm = 0; mm < 4; ++mm) ot[mm] = f32x4{0.f, 0.f, 0.f, 0.f};
  const u16* zp_ = p.P + tokq * NP + ZB + h * 64 + 4 * fq;
  const uint2 zq0 = *(const uint2*)(zp_), zq1 = *(const uint2*)(zp_ + 16), zq2 = *(const uint2*)(zp_ + 32), zq3 = *(const uint2*)(zp_ + 48);
  __builtin_amdgcn_sched_barrier(0);
  float R = 0.f;
  const float csc = 0.125f * 1.44269504088896f;
  const int lrow = tid >> 3, lch = tid & 7;
  const u16* gk = p.P + ((size_t)b * SEQ + lrow) * NP + KB + h * 64 + lch * 8;
  const u16* gv = p.P + ((size_t)b * SEQ + lrow) * NP + VB + h * 64 + lch * 8;
  uint4 rk0, rk1, rv0, rv1;
  __syncthreads();
  rk0 = *(const uint4*)(gk + (size_t)(qb * 64) * NP);
  rk1 = *(const uint4*)(gk + (size_t)(qb * 64 + 32) * NP);
  rv0 = *(const uint4*)(gv + (size_t)(qb * 64) * NP);
  rv1 = *(const uint4*)(gv + (size_t)(qb * 64 + 32) * NP);
  *(uint4*)(sK + lrow * 72 + lch * 8) = rk0;
  *(uint4*)(sK + (lrow + 32) * 72 + lch * 8) = rk1;
  *(uint4*)(sV + lrow * 72 + lch * 8) = rv0;
  *(uint4*)(sV + (lrow + 32) * 72 + lch * 8) = rv1;
  __syncthreads();
  int cur = 0;
  for (int kt = qb; kt >= 0; --kt) {
    {
      const int kn = kt > 0 ? kt - 1 : 0;
      rk0 = *(const uint4*)(gk + (size_t)(kn * 64) * NP);
      rk1 = *(const uint4*)(gk + (size_t)(kn * 64 + 32) * NP);
      rv0 = *(const uint4*)(gv + (size_t)(kn * 64) * NP);
      rv1 = *(const uint4*)(gv + (size_t)(kn * 64 + 32) * NP);
    }
    __builtin_amdgcn_sched_barrier(0);
    const u16* cK = sK + cur * 64 * 72;
    const u16* cV = sV + cur * 64 * 72;
    f32x4 st[4];
#pragma unroll
    for (int m = 0; m < 4; ++m) {
      st[m] = f32x4{0.f, 0.f, 0.f, 0.f};
#pragma unroll
      for (int ks = 0; ks < 2; ++ks)
        st[m] = __builtin_amdgcn_mfma_f32_16x16x32_bf16(*(const bf16x8*)(cK + (16 * m + fr) * 72 + 32 * ks + 8 * fq), qf[ks], st[m], 0, 0, 0);
    }
    float lk[4][4], lb[4][4], G[4], T[4], E[4];
#pragma unroll
    for (int m = 0; m < 4; ++m) {
#pragma unroll
      for (int j = 0; j < 4; ++j) {
        const float z2 = st[m][j] * csc;
        const float sp = fmaxf(z2, 0.f) + lg2(1.f + ex2(-fabsf(z2)));
        const bool valid = kt != qb || (kt * 64 + 16 * m + 4 * fq + j) < tq;
        lk[m][j] = valid ? -sp : 0.f;
        lb[m][j] = valid ? z2 - sp : -1e30f;
      }
      G[m] = (lk[m][0] + lk[m][1]) + (lk[m][2] + lk[m][3]);
    }
#pragma unroll
    for (int m = 0; m < 4; ++m) {
      const float a = __shfl_xor(G[m], 16);
      const float s1 = G[m] + a;
      const float c2 = __shfl_xor(s1, 32);
      T[m] = s1 + c2;
      E[m] = fq == 0 ? (a + c2) : (fq == 1 ? c2 : (fq == 2 ? a : 0.f));
    }
    float base = R;
    f32x4 wt[4];
#pragma unroll
    for (int m = 3; m >= 0; --m) {
      float e = base + E[m];
#pragma unroll
      for (int j = 3; j >= 0; --j) {
        wt[m][j] = ex2(lb[m][j] + e);
        e += lk[m][j];
      }
      base += T[m];
    }
    R = base;
    bf16x8 pb[2];
    pb[0] = packB(wt[0], wt[1]);
    pb[1] = packB(wt[2], wt[3]);
#pragma unroll
    for (int mm = 0; mm < 4; ++mm)
#pragma unroll
      for (int k2 = 0; k2 < 2; ++k2)
        ot[mm] = __builtin_amdgcn_mfma_f32_16x16x32_bf16(vt_frag(cV, 32 * k2, mm, lane), pb[k2], ot[mm], 0, 0, 0);
    {
      u16* nK = sK + (cur ^ 1) * 64 * 72;
      u16* nV = sV + (cur ^ 1) * 64 * 72;
      *(uint4*)(nK + lrow * 72 + lch * 8) = rk0;
      *(uint4*)(nK + (lrow + 32) * 72 + lch * 8) = rk1;
      *(uint4*)(nV + lrow * 72 + lch * 8) = rv0;
      *(uint4*)(nV + (lrow + 32) * 72 + lch * 8) = rv1;
    }
    __syncthreads();
    cur ^= 1;
  }
#pragma unroll
  for (int mm = 0; mm < 4; ++mm) {
    const int dh = 16 * mm + 4 * fq;
    const uint2 zr = mm == 0 ? zq0 : (mm == 1 ? zq1 : (mm == 2 ? zq2 : zq3));
    const unsigned zx = zr.x, zy = zr.y;
    const float z0 = __uint_as_float(zx << 16), z1 = __uint_as_float(zx & 0xffff0000u);
    const float z2 = __uint_as_float(zy << 16), z3 = __uint_as_float(zy & 0xffff0000u);
    uint2 o;
    o.x = pk2(ot[mm][0] * silu(z0), ot[mm][1] * silu(z1));
    o.y = pk2(ot[mm][2] * silu(z2), ot[mm][3] * silu(z3));
    *(uint2*)(p.mixed + tokq * MLD + 384 + h * 64 + dh) = o;
  }
}

__device__ void dil_mfma(const Params& p, int unit, char* smem) {
  const int tid = otid(), lane = tid & 63, w = tid >> 6, fr = lane & 15, fq = lane >> 4;
  u16* sV = (u16*)smem + w * (32 * 72);
  const int rq = unit & 3, a = (unit >> 2) & 7, bh = unit >> 5, b = bh / 6, h = bh % 6;
  const int r = 4 * rq + w;
  const int tq = r + 16 * (16 * a + fr);
  const size_t tokq = (size_t)b * SEQ + tq;
  bf16x8 qf[2];
#pragma unroll
  for (int ks = 0; ks < 2; ++ks) qf[ks] = *(const bf16x8*)(p.P + tokq * NP + QC + h * 64 + 32 * ks + 8 * fq);
  f32x4 ot[4];
#pragma unroll
  for (int mm = 0; mm < 4; ++mm) ot[mm] = f32x4{0.f, 0.f, 0.f, 0.f};
  float Ls = 0.f;
  const u16* zp_ = p.P + tokq * NP + ZC + h * 64 + 4 * fq;
  const uint2 zq0 = *(const uint2*)(zp_), zq1 = *(const uint2*)(zp_ + 16), zq2 = *(const uint2*)(zp_ + 32), zq3 = *(const uint2*)(zp_ + 48);
  __builtin_amdgcn_sched_barrier(0);
  const float csc = 0.125f * 1.44269504088896f;
  const u16* kbase = p.P + (size_t)b * SEQ * NP + KC + h * 64;
  const u16* vbase = p.P + (size_t)b * SEQ * NP + VC + h * 64;
  int g = 0, stp = 0;
  int d = 1, rr = 0, lo = r + 256 * a - 128, nsteps = 12, iq = r + 256 * a + 16 * fr, imax = SEQ - 1;
  bf16x8 k00, k01, k10, k11;
  uint4 v0, v1, v2, v3;
#define DIL_LOAD(d_, rr_, i0_, imax_)                                                            \
  {                                                                                              \
    const int ib_ = (i0_) + (lane >> 3);                                                         \
    const u16* vb_ = vbase + (lane & 7) * 8;                                                     \
    v0 = *(const uint4*)(vb_ + (size_t)((rr_) + (d_) * min(max(ib_, 0), (imax_))) * NP);         \
    v1 = *(const uint4*)(vb_ + (size_t)((rr_) + (d_) * min(max(ib_ + 8, 0), (imax_))) * NP);     \
    v2 = *(const uint4*)(vb_ + (size_t)((rr_) + (d_) * min(max(ib_ + 16, 0), (imax_))) * NP);    \
    v3 = *(const uint4*)(vb_ + (size_t)((rr_) + (d_) * min(max(ib_ + 24, 0), (imax_))) * NP);    \
    const u16* ka_ = kbase + (size_t)((rr_) + (d_) * min(max((i0_) + fr, 0), (imax_))) * NP + 8 * fq;       \
    const u16* kb_ = kbase + (size_t)((rr_) + (d_) * min(max((i0_) + 16 + fr, 0), (imax_))) * NP + 8 * fq;  \
    k00 = *(const bf16x8*)(ka_); k01 = *(const bf16x8*)(ka_ + 32);                               \
    k10 = *(const bf16x8*)(kb_); k11 = *(const bf16x8*)(kb_ + 32);                               \
  }
  DIL_LOAD(d, rr, lo, imax);
  while (g < 3) {
    const bf16x8 c00 = k00, c01 = k01, c10 = k10, c11 = k11;
    const uint4 w0 = v0, w1 = v1, w2 = v2, w3 = v3;
    const int i0 = lo + 32 * stp, iqc = iq;
    int ng = g, nstp = stp + 1;
    if (nstp >= nsteps) { ng = g + 1; nstp = 0; }
    if (ng != g) {
      if (ng == 1) { d = 4; rr = r & 3; lo = (r >> 2) + 64 * a - 128; nsteps = 6; iq = (r >> 2) + 64 * a + 4 * fr; imax = SEQ / 4 - 1; }
      else { d = 16; rr = r; lo = 0; nsteps = (a + 2) >> 1; iq = 16 * a + fr; imax = SEQ / 16 - 1; }
    }
    g = ng; stp = nstp;
    DIL_LOAD(d, rr, lo + 32 * stp, imax);
    __builtin_amdgcn_sched_barrier(0);
    f32x4 st0 = {0.f, 0.f, 0.f, 0.f}, st1 = {0.f, 0.f, 0.f, 0.f};
    st0 = __builtin_amdgcn_mfma_f32_16x16x32_bf16(c00, qf[0], st0, 0, 0, 0);
    st0 = __builtin_amdgcn_mfma_f32_16x16x32_bf16(c01, qf[1], st0, 0, 0, 0);
    st1 = __builtin_amdgcn_mfma_f32_16x16x32_bf16(c10, qf[0], st1, 0, 0, 0);
    st1 = __builtin_amdgcn_mfma_f32_16x16x32_bf16(c11, qf[1], st1, 0, 0, 0);
    {
      u16* dv = sV + (lane >> 3) * 72 + (lane & 7) * 8;
      *(uint4*)(dv) = w0; *(uint4*)(dv + 8 * 72) = w1; *(uint4*)(dv + 16 * 72) = w2; *(uint4*)(dv + 24 * 72) = w3;
    }
    f32x4 wt0, wt1;
    const int vlo = iqc - 128 > 0 ? iqc - 128 : 0;
    const unsigned vspan = (unsigned)(iqc - vlo);
    const int vb = i0 + 4 * fq - vlo;
#pragma unroll
    for (int j = 0; j < 4; ++j) {
      const unsigned d0 = (unsigned)(vb + j), d1 = d0 + 16u;
      const float e0 = d0 <= vspan ? ex2(st0[j] * csc) : 0.f;
      const float e1 = d1 <= vspan ? ex2(st1[j] * csc) : 0.f;
      wt0[j] = e0; wt1[j] = e1;
      Ls += e0 + e1;
    }
    const bf16x8 pb = packB(wt0, wt1);
#pragma unroll
    for (int mm = 0; mm < 4; ++mm)
      ot[mm] = __builtin_amdgcn_mfma_f32_16x16x32_bf16(vt_frag(sV, 0, mm, lane), pb, ot[mm], 0, 0, 0);
  }
#undef DIL_LOAD
  Ls += __shfl_xor(Ls, 16);
  Ls += __shfl_xor(Ls, 32);
  const float il = 1.f / Ls;
#pragma unroll
  for (int mm = 0; mm < 4; ++mm) {
    const int dh = 16 * mm + 4 * fq;
    const uint2 zr = mm == 0 ? zq0 : (mm == 1 ? zq1 : (mm == 2 ? zq2 : zq3));
    const unsigned zx = zr.x, zy = zr.y;
    const float z0 = __uint_as_float(zx << 16), z1 = __uint_as_float(zx & 0xffff0000u);
    const float z2 = __uint_as_float(zy << 16), z3 = __uint_as_float(zy & 0xffff0000u);
    uint2 o;
    o.x = pk2(ot[mm][0] * il * silu(z0), ot[mm][1] * il * silu(z1));
    o.y = pk2(ot[mm][2] * il * silu(z2), ot[mm][3] * il * silu(z3));
    *(uint2*)(p.mixed + tokq * MLD + 640 + h * 64 + dh) = o;
  }
}

__device__ void phase_mix(const Params& p, int layer, char* smem, int bid, int nblk) {
  const int nG = 96, nS = 64 * 32, nD = 96 * 32;
  __shared__ int s_unit;
  for (;;) {
    __syncthreads();
    if (otid() == 0) s_unit = atomicAdd(p.ctr + layer, 1);
    __syncthreads();
    const int u = s_unit;
    if (u >= nG + nS + nD) break;
    if (u < nG) gdn_rec(p, layer, u, smem);
    else if (u < nG + nS) sb_mfma(p, u - nG, smem);
    else dil_mfma(p, u - nG - nS, smem);
  }
}


#define XB_TMO      128
#define XB_XCNT(j)  (256  + 64 * (j))
#define XB_XSUB(j)  (1280 + 64 * (j))
#define XB_XGEN(j)  (2304 + 64 * (j))
#define XB_TOP      3328
#define XB_TOPGEN   3392
#define XCD_BAR_WORDS 3456
#define XB_SPIN_CAP (1u << 20)
#define LAS __attribute__((address_space(3)))
DI unsigned xb_ld(unsigned* p) { return __hip_atomic_load(p, __ATOMIC_RELAXED, __HIP_MEMORY_SCOPE_AGENT); }
DI unsigned xb_add(unsigned* p, unsigned v) { return __hip_atomic_fetch_add(p, v, __ATOMIC_RELAXED, __HIP_MEMORY_SCOPE_AGENT); }
DI unsigned xb_xcc_id() { return (unsigned)__builtin_amdgcn_s_getreg((3 << 11) | 20) & 0xFu; }
#define XB_SPIN(cond, bar) do { unsigned _sp = 0; while (cond) { __builtin_amdgcn_s_sleep(1); \
    if ((++_sp & 255u) == 0u) { if (xb_ld(&(bar)[XB_TMO])) break; if (_sp > XB_SPIN_CAP) { atomicAdd(&(bar)[XB_TMO], 1u); break; } } } } while (0)
struct XcdBarrier { unsigned* bar; unsigned x; volatile LAS unsigned* st; };
DI XcdBarrier xcd_barrier_post(unsigned* bar, volatile LAS unsigned* st) {
  XcdBarrier b; b.bar = bar; b.x = xb_xcc_id(); b.st = st;
  if (threadIdx.x == 0) (void)xb_add(&bar[XB_XCNT(b.x)], 1u);
  return b;
}
DI void xcd_barrier_complete(unsigned* bar, unsigned x, unsigned& nloc, unsigned& nx) {
  const unsigned G = gridDim.x * gridDim.y * gridDim.z;
  unsigned sum, cnt, mine, sp = 0u;
  for (;;) {
    sum = 0u; cnt = 0u; mine = 0u;
#pragma unroll
    for (unsigned j = 0; j < 16; ++j) { const unsigned c = xb_ld(&bar[XB_XCNT(j)]); sum += c; cnt += (c > 0u) ? 1u : 0u; mine = (j == x) ? c : mine; }
    if (sum == G) break;
    __builtin_amdgcn_s_sleep(1);
    if ((++sp & 255u) == 0u) { if (xb_ld(&bar[XB_TMO])) break; if (sp > XB_SPIN_CAP) { atomicAdd(&bar[XB_TMO], 1u); break; } }
  }
  nloc = mine > 0u ? mine : 1u; nx = cnt > 0u ? cnt : 1u;
}
DI void xcd_barrier(const XcdBarrier& b) {
  asm volatile("s_waitcnt vmcnt(0)" ::: "memory");
  __syncthreads();
  if (threadIdx.x == 0) {
    unsigned* bar = b.bar;
    __builtin_amdgcn_s_waitcnt(0);
    unsigned nloc = b.st[0], nx = b.st[1];
    if (nloc == 0u) { xcd_barrier_complete(bar, b.x, nloc, nx); b.st[0] = nloc; b.st[1] = nx; }
    const unsigned old = xb_add(&bar[XB_XSUB(b.x)], 1u);
    const unsigned gen = old / nloc;
    if (old + 1u == (gen + 1u) * nloc) {
      __builtin_amdgcn_fence(__ATOMIC_RELEASE, "agent");
      asm volatile("s_waitcnt vmcnt(0)" ::: "memory");
      const unsigned og = xb_add(&bar[XB_TOP], 1u);
      const unsigned tg = og / nx;
      if (og + 1u == (tg + 1u) * nx) xb_add(&bar[XB_TOPGEN], 1u);
      else XB_SPIN(xb_ld(&bar[XB_TOPGEN]) == tg, bar);
      __builtin_amdgcn_fence(__ATOMIC_ACQUIRE, "agent");
      xb_add(&bar[XB_XGEN(b.x)], 1u);
      asm volatile("s_waitcnt vmcnt(0)" ::: "memory");
    } else {
      XB_SPIN(xb_ld(&bar[XB_XGEN(b.x)]) == gen, bar);
      __builtin_amdgcn_fence(__ATOMIC_ACQUIRE, "agent");
      asm volatile("s_waitcnt vmcnt(0)" ::: "memory");
    }
  }
  __syncthreads();
}

constexpr int SMEM_BYTES = 70144;

__global__ void __launch_bounds__(256, 2) mega(Params p, int ph_lo, int ph_hi) {
  __shared__ __attribute__((aligned(16))) char smem[SMEM_BYTES];
  const int bid = blockIdx.x, nblk = gridDim.x;
  __shared__ uint4 xb_words;
  if (threadIdx.x == 0) xb_words = make_uint4(0u, 0u, 0u, 0u);
  __syncthreads();
  const XcdBarrier xb = xcd_barrier_post(p.bar, (volatile LAS unsigned*)&xb_words);
  if (ph_hi < 0) cg::this_grid().sync();
  for (int ph = ph_lo; ph < ph_hi; ++ph) {
    if (ph > ph_lo) {
      xcd_barrier(xb);
    }
    if (ph == 0) { phase_prep(p, (float*)smem, bid, nblk); continue; }
    const int layer = (ph - 1) / 4, sub = (ph - 1) % 4;
    if (sub == 0) { for (int r = 0; r < REP_IN; ++r) phase_inproj(p, layer, smem, bid, nblk); }
    else if (sub == 1) phase_qknorm(p, layer, smem, bid, nblk);
    else if (sub == 2) { for (int r = 0; r < REP_MIX; ++r) phase_mix(p, layer, smem, bid, nblk); }
    else phase_outproj(p, layer, smem, bid, nblk);
  }
}

extern "C" void kernel_launch(void* const* d_in, const int* in_sizes, int n_in, void* d_out, int out_size,
                              void* d_ws, size_t ws_size, hipStream_t stream) {
  Params p{};
  p.x = (const float*)d_in[0]; p.norm_w = (const float*)d_in[1]; p.w_in = (const float*)d_in[2];
  p.conv_w = (const float*)d_in[3]; p.a_log = (const float*)d_in[4]; p.dt_bias = (const float*)d_in[5];
  p.gdn_norm_w = (const float*)d_in[6]; p.q_norm_w = (const float*)d_in[7]; p.k_norm_w = (const float*)d_in[8];
  p.w_out = (const float*)d_in[9];
  p.out = (float*)d_out;
  char* ws = (char*)d_ws;
  size_t off = 0;
  auto take = [&](size_t bytes) { char* r = ws + off; off += (bytes + 255) & ~(size_t)255; return r; };
  p.WinT = (u16*)take((size_t)2 * NPAD * DM * 2);
  p.WoutT = (u16*)take((size_t)2 * DM * DM * 2);
  p.P = (u16*)take((size_t)NTOK * NP * 2);
  p.BA = (float*)take((size_t)NTOK * 16 * 4);
  p.mixed = p.P;
  p.xb = (u16*)take((size_t)NTOK * DM * 2);
  const size_t nch = (size_t)96 * 32 * 4096;
  p.gU = (float*)take(nch * 4);
  p.gW = (u16*)take(nch * 2);
  p.gQK = (u16*)take(nch * 2);
  p.gQG = (u16*)take(nch * 2);
  p.gKGt = (u16*)take(nch * 2);
  p.gGL = (float*)take((size_t)96 * 32 * 4);
  p.ropeT = (float*)take((size_t)SEQ * 8 * 2 * 4);
  p.ctr = (int*)take(256);
  p.bar = (unsigned*)take((size_t)XCD_BAR_WORDS * 4);
  static int grid_blocks = 0;
  if (!grid_blocks) {
    int dev = 0, cus = 0, per_cu = 0;
    hipGetDevice(&dev);
    hipDeviceGetAttribute(&cus, hipDeviceAttributeMultiprocessorCount, dev);
    hipOccupancyMaxActiveBlocksPerMultiprocessor(&per_cu, mega, 256, 0);
    if (per_cu < 1) per_cu = 1;
    if (per_cu > 2) per_cu = 2;
    grid_blocks = cus * per_cu;
  }
  hipMemsetAsync(p.bar, 0, (size_t)XCD_BAR_WORDS * 4, stream);
#if COOP
  int lo = 0, hi = 9;
  void* args[] = {&p, &lo, &hi};
  hipError_t e = hipLaunchCooperativeKernel((void*)mega, dim3(grid_blocks), dim3(256), args, 0, stream);
  if (e != hipSuccess) fprintf(stderr, "cooperative launch failed: %s (grid %d)\n", hipGetErrorString(e), grid_blocks);
#else
  for (int ph = 0; ph < 9; ++ph) mega<<<grid_blocks, 256, 0, stream>>>(p, ph, ph + 1);
#endif
}
```

```cpp
#include <hip/hip_runtime.h>
#include <hip/hip_bf16.h>
#include <hip/hip_cooperative_groups.h>
#include <cstdio>
namespace cg = cooperative_groups;

typedef unsigned short u16;
using bf16x8 = __attribute__((ext_vector_type(8))) short;
using f32x4 = __attribute__((ext_vector_type(4))) float;
typedef __bf16 bf16x2_t __attribute__((ext_vector_type(2)));

#define DI __device__ __forceinline__

constexpr int NB = 16, SEQ = 2048, DM = 1024, NTOK = NB * SEQ;
constexpr int NP = 4096;
constexpr int NPAD = 4224;
constexpr int INC = 4108;
constexpr int MLD = NP;
constexpr int QA = 0, KA = 384, VA = 768, ZA = 1152, QB = 1536, KB = 1792, VB = 2048, ZB = 2304,
              QC = 2560, KC = 2944, VC = 3328, ZC = 3712;

#ifndef COOP
#define COOP 1
#endif
#define REP_IN 1
#define REP_MIX 1

struct Params {
  const float *x, *norm_w, *w_in, *conv_w, *a_log, *dt_bias, *gdn_norm_w, *q_norm_w, *k_norm_w, *w_out;
  float* out;
  u16 *WinT, *WoutT, *xb, *P, *mixed;
  float* BA;
  float *gU, *gGL, *ropeT;
  int* ctr;
  unsigned* bar;
  u16 *gW, *gQK, *gQG, *gKGt;
};

typedef float f32x2_t __attribute__((ext_vector_type(2)));
DI unsigned pk2(float lo, float hi) {
  const f32x2_t v = {lo, hi};
  return __builtin_bit_cast(unsigned, __builtin_convertvector(v, bf16x2_t));
}
DI u16 f2bf(float x) { return (u16)(pk2(x, 0.f) & 0xffffu); }
DI float bf2f(u16 h) { return __uint_as_float(((unsigned)h) << 16); }
DI float ex2(float x) { return __builtin_amdgcn_exp2f(x); }
DI float lg2(float x) { return __builtin_amdgcn_logf(x); }
DI float fexp(float x) { return ex2(x * 1.44269504088896f); }
DI float silu(float x) { return x * __builtin_amdgcn_rcpf(1.f + fexp(-x)); }
DI float softplus(float x) { return fmaxf(x, 0.f) + log1pf(expf(-fabsf(x))); }
DI float sigmoidf(float x) { return 1.f / (1.f + expf(-x)); }
DI int otid() { int t = threadIdx.x; asm volatile("" : "+v"(t)); return t; }
DI float wave_sum(float v) {
#pragma unroll
  for (int o = 32; o > 0; o >>= 1) v += __shfl_xor(v, o);
  return v;
}

DI int perm_col(int n) {
  if (n < 1536) return n;
  if (n < 4096) return n + 12;
  if (n < 4108) return 1536 + (n - 4096);
  return -1;
}

__device__ void phase_prep(const Params& p, float* smem, int bid, int nblk) {
  const int tid = otid();
  {
    const size_t n8 = (size_t)NTOK * DM / 8;
    for (size_t i = (size_t)bid * 256 + tid; i < n8; i += (size_t)nblk * 256) {
      const float4 a = ((const float4*)p.x)[2 * i], b = ((const float4*)p.x)[2 * i + 1];
      uint4 o;
      o.x = f2bf(a.x) | ((unsigned)f2bf(a.y) << 16);
      o.y = f2bf(a.z) | ((unsigned)f2bf(a.w) << 16);
      o.z = f2bf(b.x) | ((unsigned)f2bf(b.y) << 16);
      o.w = f2bf(b.z) | ((unsigned)f2bf(b.w) << 16);
      ((uint4*)p.xb)[i] = o;
    }
  }
  if (bid == 0 && tid < 8) p.ctr[tid] = 0;
  for (int i = bid * 256 + tid; i < SEQ * 8; i += nblk * 256) {
    const int t = i >> 3, f = i & 7;
    const float ang = (float)t * powf(500000.f, -(float)f / 8.f);
    p.ropeT[2 * i] = cosf(ang);
    p.ropeT[2 * i + 1] = sinf(ang);
  }
  const int nWin = 2 * (NPAD / 64) * 16, nWout = 2 * 16 * 16;
  float (*tile)[65] = (float (*)[65])smem;
  for (int u = bid; u < nWin + nWout; u += nblk) {
    const bool isin = u < nWin;
    int l, nt, kt;
    if (isin) { l = u / ((NPAD / 64) * 16); int r = u % ((NPAD / 64) * 16); nt = r / 16; kt = r % 16; }
    else { int v = u - nWin; l = v / 256; int r = v % 256; nt = r / 16; kt = r % 16; }
    const int tx = tid & 63, ty = tid >> 6;
    const int n = nt * 64 + tx;
    const int c = isin ? perm_col(n) : n;
    const float* src = isin ? p.w_in + (size_t)l * DM * INC : p.w_out + (size_t)l * DM * DM;
    const int ld = isin ? INC : DM;
    {
      const int cc = c >= 0 ? c : 0;
      const float msk = c >= 0 ? 1.f : 0.f;
      float wv[16], nwv[16];
#pragma unroll
      for (int i = 0; i < 16; ++i) {
        const int k = kt * 64 + ty + 4 * i;
        wv[i] = src[(size_t)k * ld + cc];
        nwv[i] = isin ? p.norm_w[l * DM + k] : 1.f;
      }
#pragma unroll
      for (int i = 0; i < 16; ++i) tile[ty + 4 * i][tx] = wv[i] * nwv[i] * msk;
    }
    __syncthreads();
    u16* dst = isin ? p.WinT + (size_t)l * NPAD * DM : p.WoutT + (size_t)l * DM * DM;
    for (int nn = ty; nn < 64; nn += 4)
      dst[(size_t)(nt * 64 + nn) * DM + kt * 64 + tx] = f2bf(tile[tx][nn]);
    __syncthreads();
  }
}

constexpr int LDT2 = 32;
template <int MODE>
__device__ void gemm_tile(const Params& p, const u16* __restrict__ A, const u16* __restrict__ Bt,
                          int mt, int nt, int layer, const float* resid, char* smem) {
  u16* sA = (u16*)smem;
  u16* sB = sA + 2 * 256 * LDT2;
  float* rs = (float*)(sB + 2 * 128 * LDT2);
  const int tid = otid(), lane = tid & 63, w = tid >> 6, wr = w >> 1, wc = w & 1;
  const int fr = lane & 15, fq = lane >> 4;
  const int lrow = tid >> 2, lch = tid & 3;
  const int wsw = lch ^ ((0x1320 >> (4 * ((lrow >> 2) & 3))) & 3);
  const int rsw = fq ^ ((0x1320 >> (4 * ((fr >> 2) & 3))) & 3);
  const size_t m0 = (size_t)mt * 256, n0 = (size_t)nt * 128;
  constexpr int K = DM, NK = K / 32;
  constexpr int LDA = MODE == 0 ? DM : MLD;
  f32x4 acc[8][4];
#pragma unroll
  for (int i = 0; i < 8; ++i)
#pragma unroll
    for (int j = 0; j < 4; ++j) acc[i][j] = f32x4{0.f, 0.f, 0.f, 0.f};
  float ss0 = 0.f, ss1 = 0.f, ss2 = 0.f, ss3 = 0.f;
  const char* bA = (const char*)(A + m0 * LDA);
  const char* bB = (const char*)(Bt + n0 * K);
  const unsigned vA = (unsigned)(lrow * LDA + lch * 8) * 2u;
  const unsigned vB = (unsigned)(lrow * K + lch * 8) * 2u;
#define G2_LOAD(S_, kt_)                                                 \
  {                                                                      \
    const unsigned ko_ = (unsigned)(kt_) * 64u;                          \
    S_##a0 = *(const uint4*)(bA + (vA + ko_));                           \
    S_##a1 = *(const uint4*)(bA + (size_t)64 * LDA * 2 + (vA + ko_));    \
    S_##a2 = *(const uint4*)(bA + (size_t)128 * LDA * 2 + (vA + ko_));   \
    S_##a3 = *(const uint4*)(bA + (size_t)192 * LDA * 2 + (vA + ko_));   \
    S_##b0 = *(const uint4*)(bB + (vB + ko_));                           \
    S_##b1 = *(const uint4*)(bB + (size_t)64 * K * 2 + (vB + ko_));      \
  }
#define G2_SSQ(acc_, v_)                                                                          \
  {                                                                                               \
    acc_ = __builtin_amdgcn_fdot2_f32_bf16(__builtin_bit_cast(bf16x2_t, v_.x), __builtin_bit_cast(bf16x2_t, v_.x), acc_, false); \
    acc_ = __builtin_amdgcn_fdot2_f32_bf16(__builtin_bit_cast(bf16x2_t, v_.y), __builtin_bit_cast(bf16x2_t, v_.y), acc_, false); \
    acc_ = __builtin_amdgcn_fdot2_f32_bf16(__builtin_bit_cast(bf16x2_t, v_.z), __builtin_bit_cast(bf16x2_t, v_.z), acc_, false); \
    acc_ = __builtin_amdgcn_fdot2_f32_bf16(__builtin_bit_cast(bf16x2_t, v_.w), __builtin_bit_cast(bf16x2_t, v_.w), acc_, false); \
  }
#define G2_STASH(S_, buf_)                                               \
  {                                                                      \
    u16* dA_ = sA + ((buf_) * 256 + lrow) * LDT2 + wsw * 8;              \
    u16* dB_ = sB + ((buf_) * 128 + lrow) * LDT2 + wsw * 8;              \
    *(uint4*)(dA_) = S_##a0;                                             \
    *(uint4*)(dA_ + 64 * LDT2) = S_##a1;                                 \
    *(uint4*)(dA_ + 128 * LDT2) = S_##a2;                                \
    *(uint4*)(dA_ + 192 * LDT2) = S_##a3;                                \
    *(uint4*)(dB_) = S_##b0;                                             \
    *(uint4*)(dB_ + 64 * LDT2) = S_##b1;                                 \
    if (MODE == 0) { G2_SSQ(ss0, S_##a0) G2_SSQ(ss1, S_##a1) G2_SSQ(ss2, S_##a2) G2_SSQ(ss3, S_##a3) } \
  }
#define G2_COMPUTE(cur_)                                                                                   \
  {                                                                                                        \
    bf16x8 bfr[4], af[8];                                                                                  \
    _Pragma("unroll") for (int n = 0; n < 4; ++n)                                                          \
      bfr[n] = *(const bf16x8*)(sB + ((cur_) * 128 + wc * 64 + n * 16 + fr) * LDT2 + rsw * 8);             \
    _Pragma("unroll") for (int m = 0; m < 8; ++m)                                                          \
      af[m] = *(const bf16x8*)(sA + ((cur_) * 256 + wr * 128 + m * 16 + fr) * LDT2 + rsw * 8);             \
    _Pragma("unroll") for (int m = 0; m < 8; ++m)                                                          \
      _Pragma("unroll") for (int n = 0; n < 4; ++n)                                                        \
        acc[m][n] = __builtin_amdgcn_mfma_f32_16x16x32_bf16(af[m], bfr[n], acc[m][n], 0, 0, 0);           \
                      \
    __builtin_amdgcn_sched_group_barrier(0x100, 6, 0);                                                     \
    _Pragma("unroll") for (int m = 0; m < 6; ++m) {                                                        \
      __builtin_amdgcn_sched_group_barrier(0x008, 4, 0);                                                   \
      __builtin_amdgcn_sched_group_barrier(0x100, 1, 0);                                                   \
    }                                                                                                      \
    __builtin_amdgcn_sched_group_barrier(0x008, 8, 0);                                                     \
  }
  uint4 Xa0, Xa1, Xa2, Xa3, Xb0, Xb1, Ya0, Ya1, Ya2, Ya3, Yb0, Yb1;
  __syncthreads();
  G2_LOAD(X, 0);
  G2_LOAD(Y, 1);
  G2_STASH(X, 0);
  __syncthreads();
  for (int kt = 0; kt < NK; kt += 2) {
    { const int k2 = kt + 2 < NK ? kt + 2 : NK - 1; G2_LOAD(X, k2); }
    G2_COMPUTE(0);
    G2_STASH(Y, 1);
    __syncthreads();
    { const int k3 = kt + 3 < NK ? kt + 3 : NK - 1; G2_LOAD(Y, k3); }
    G2_COMPUTE(1);
    if (kt + 2 < NK) G2_STASH(X, 0);
    __syncthreads();
  }
#undef G2_LOAD
#undef G2_STASH
#undef G2_COMPUTE
#undef G2_SSQ
  if (MODE == 0) {
    {
      float s0 = ss0, s1 = ss1, s2 = ss2, s3 = ss3;
      s0 += __shfl_xor(s0, 1); s0 += __shfl_xor(s0, 2);
      s1 += __shfl_xor(s1, 1); s1 += __shfl_xor(s1, 2);
      s2 += __shfl_xor(s2, 1); s2 += __shfl_xor(s2, 2);
      s3 += __shfl_xor(s3, 1); s3 += __shfl_xor(s3, 2);
      if (lch == 0) {
        rs[lrow] = rsqrtf(s0 * (1.f / DM) + 1e-6f);
        rs[lrow + 64] = rsqrtf(s1 * (1.f / DM) + 1e-6f);
        rs[lrow + 128] = rsqrtf(s2 * (1.f / DM) + 1e-6f);
        rs[lrow + 192] = rsqrtf(s3 * (1.f / DM) + 1e-6f);
      }
    }
    __syncthreads();
    const bool isqk = false;
    if (isqk) {
      const float* nwp = (nt >= 23 ? p.k_norm_w : p.q_norm_w) + layer * 64;
      float nwv[4];
#pragma unroll
      for (int n = 0; n < 4; ++n) nwv[n] = nwp[16 * n + fr];
#pragma unroll
      for (int m = 0; m < 8; ++m)
#pragma unroll
        for (int j = 0; j < 4; ++j) {
          const int row = wr * 128 + m * 16 + fq * 4 + j;
          const float r = rs[row];
          float v[4];
          float sq = 0.f;
#pragma unroll
          for (int n = 0; n < 4; ++n) { v[n] = acc[m][n][j] * r; sq += v[n] * v[n]; }
          sq += __shfl_xor(sq, 1); sq += __shfl_xor(sq, 2); sq += __shfl_xor(sq, 4); sq += __shfl_xor(sq, 8);
          const float rr = rsqrtf(sq * (1.f / 64.f) + 1e-6f);
#pragma unroll
          for (int n = 0; n < 4; ++n) v[n] = v[n] * rr * nwv[n];
          const float partner = __shfl_xor(v[0], 8);
          const int t = (int)((m0 + row) & (SEQ - 1));
          const float2 cssn = *(const float2*)(p.ropeT + ((size_t)t * 8 + (fr & 7)) * 2);
          v[0] = fr < 8 ? v[0] * cssn.x - partner * cssn.y : v[0] * cssn.x + partner * cssn.y;
#pragma unroll
          for (int n = 0; n < 4; ++n) p.P[(m0 + row) * NP + n0 + wc * 64 + n * 16 + fr] = f2bf(v[n]);
        }
    } else {
#pragma unroll
      for (int m = 0; m < 8; ++m)
#pragma unroll
        for (int j = 0; j < 4; ++j) {
          const int row = wr * 128 + m * 16 + fq * 4 + j;
          const float r = rs[row];
#pragma unroll
          for (int n = 0; n < 4; ++n) {
            const int col = wc * 64 + n * 16 + fr;
            const float v = acc[m][n][j] * r;
            if (nt < 32) p.P[(m0 + row) * NP + n0 + col] = f2bf(v);
            else if (col < 16) p.BA[(m0 + row) * 16 + col] = v;
          }
        }
    }
  } else {
#pragma unroll
    for (int m = 0; m < 8; ++m) {
      float rv[16];
#pragma unroll
      for (int j = 0; j < 4; ++j)
#pragma unroll
        for (int n = 0; n < 4; ++n) {
          const float* ptr_ = resid + (m0 + wr * 128 + m * 16 + fq * 4 + j) * DM + n0 + wc * 64 + n * 16 + fr;
          asm volatile("global_load_dword %0, %1, off" : "=v"(rv[j * 4 + n]) : "v"(ptr_) : "memory");
        }
      asm volatile("s_waitcnt vmcnt(0)"
                   : "+v"(rv[0]), "+v"(rv[1]), "+v"(rv[2]), "+v"(rv[3]), "+v"(rv[4]), "+v"(rv[5]), "+v"(rv[6]), "+v"(rv[7]),
                     "+v"(rv[8]), "+v"(rv[9]), "+v"(rv[10]), "+v"(rv[11]), "+v"(rv[12]), "+v"(rv[13]), "+v"(rv[14]), "+v"(rv[15])
                   :: "memory");
#pragma unroll
      for (int j = 0; j < 4; ++j)
#pragma unroll
        for (int n = 0; n < 4; ++n) {
          const size_t o = (m0 + wr * 128 + m * 16 + fq * 4 + j) * DM + n0 + wc * 64 + n * 16 + fr;
          rv[j * 4 + n] += acc[m][n][j];
          p.out[o] = rv[j * 4 + n];
        }
      if (layer == 0) {
#pragma unroll
        for (int j = 0; j < 4; ++j)
#pragma unroll
          for (int n = 0; n < 4; ++n)
            p.xb[(m0 + wr * 128 + m * 16 + fq * 4 + j) * DM + n0 + wc * 64 + n * 16 + fr] = f2bf(rv[j * 4 + n]);
      }
    }
  }
}

__device__ void phase_inproj(const Params& p, int layer, char* smem, int bid, int nblk) {
  const u16* Bt = p.WinT + (size_t)layer * NPAD * DM;
  const bool aff = (nblk & 7) == 0;
  const int x = bid & 7, slot = bid >> 3, nslot = nblk >> 3;
  const int start = aff ? slot : bid, step = aff ? nslot : nblk, total = aff ? 16 * 33 : 128 * 33;
  for (int j = start; j < total; j += step) {
    int mt, nt;
    if (aff) { const int g = j / 264, r = j % 264; mt = x * 16 + g * 8 + (r & 7); nt = r >> 3; }
    else { mt = j / 33; nt = j % 33; }
    gemm_tile<0>(p, p.xb, Bt, mt, nt, layer, nullptr, smem);
  }
}
__device__ void phase_outproj(const Params& p, int layer, char* smem, int bid, int nblk) {
  const float* resid = layer == 0 ? p.x : p.out;
  const u16* Bt = p.WoutT + (size_t)layer * DM * DM;
  const bool aff = (nblk & 7) == 0;
  const int x = bid & 7, slot = bid >> 3, nslot = nblk >> 3;
  const int start = aff ? slot : bid, step = aff ? nslot : nblk, total = aff ? 16 * 8 : 128 * 8;
  for (int j = start; j < total; j += step) {
    const int mt = aff ? x * 16 + (j >> 3) : j >> 3, nt = j & 7;
    gemm_tile<1>(p, p.mixed, Bt, mt, nt, layer, resid, smem);
  }
}

__device__ void gdn_prep(const Params& p, int layer, int ci, char* smem);
__device__ void phase_qknorm(const Params& p, int layer, char* smem, int bid, int nblk) {
  {
    const size_t nl = (size_t)NTOK * 96;
    for (size_t L = (size_t)bid * 256 + otid(); L < nl; L += (size_t)nblk * 256) {
      const int tok = (int)(L / 96), rem = (int)(L % 96), r = rem >> 3, sub = rem & 7;
      const int isk = r >= 6, t = tok & (SEQ - 1);
      u16* ptr = p.P + (size_t)tok * NP + QC + rem * 8;
      const float* nw = (isk ? p.k_norm_w : p.q_norm_w) + layer * 64 + sub * 8;
      const uint4 raw = *(const uint4*)ptr;
      float v[8];
      v[0] = __uint_as_float(raw.x << 16); v[1] = __uint_as_float(raw.x & 0xffff0000u);
      v[2] = __uint_as_float(raw.y << 16); v[3] = __uint_as_float(raw.y & 0xffff0000u);
      v[4] = __uint_as_float(raw.z << 16); v[5] = __uint_as_float(raw.z & 0xffff0000u);
      v[6] = __uint_as_float(raw.w << 16); v[7] = __uint_as_float(raw.w & 0xffff0000u);
      float ssq = 0.f;
#pragma unroll
      for (int e = 0; e < 8; ++e) ssq += v[e] * v[e];
      ssq += __shfl_xor(ssq, 1); ssq += __shfl_xor(ssq, 2); ssq += __shfl_xor(ssq, 4);
      const float rr = rsqrtf(ssq * (1.f / 64.f) + 1e-6f);
#pragma unroll
      for (int e = 0; e < 8; ++e) v[e] = v[e] * rr * nw[e];
      float pv[8];
#pragma unroll
      for (int e = 0; e < 8; ++e) pv[e] = __shfl_xor(v[e], 1);
      if (sub < 2) {
        const float4* rt = (const float4*)(p.ropeT + (size_t)t * 16);
        const float4 c0 = rt[0], c1 = rt[1], c2 = rt[2], c3 = rt[3];
        const float cs[8] = {c0.x, c0.z, c1.x, c1.z, c2.x, c2.z, c3.x, c3.z};
        const float sn[8] = {c0.y, c0.w, c1.y, c1.w, c2.y, c2.w, c3.y, c3.w};
#pragma unroll
        for (int e = 0; e < 8; ++e) v[e] = sub == 0 ? v[e] * cs[e] - pv[e] * sn[e] : v[e] * cs[e] + pv[e] * sn[e];
      }
      uint4 o;
      o.x = pk2(v[0], v[1]); o.y = pk2(v[2], v[3]); o.z = pk2(v[4], v[5]); o.w = pk2(v[6], v[7]);
      *(uint4*)ptr = o;
    }
  }
  for (int u = bid; u < 96 * 32; u += nblk) gdn_prep(p, layer, u, smem);
}

DI bf16x8 packB(const f32x4& a, const f32x4& b) {
  typedef unsigned u32x4 __attribute__((ext_vector_type(4)));
  u32x4 r;
  r[0] = pk2(a[0], a[1]); r[1] = pk2(a[2], a[3]); r[2] = pk2(b[0], b[1]); r[3] = pk2(b[2], b[3]);
  return __builtin_bit_cast(bf16x8, r);
}
DI bf16x8 ldfragP(const u16* X, int ld, int row, int ks, int fq) {
  typedef unsigned u32x4 __attribute__((ext_vector_type(4)));
  const u16* r = X + (size_t)row * ld + 32 * ks + 4 * fq;
  const uint2 lo = *(const uint2*)r, hi = *(const uint2*)(r + 16);
  u32x4 v; v[0] = lo.x; v[1] = lo.y; v[2] = hi.x; v[3] = hi.y;
  return __builtin_bit_cast(bf16x8, v);
}

__device__ void gdn_prep(const Params& p, int layer, int ci, char* smem) {
  float* Kf = (float*)smem;
  float* Vf = Kf + 64 * 65;
  float* Am = Vf + 64 * 65;
  u16* Qs = (u16*)(Am + 64 * 68);
  u16* Ks = Qs + 64 * 72;
  float* gcs = (float*)(Ks + 64 * 72);
  float* bts = gcs + 64;
  float* rsc = bts + 64;
  const int tid = otid(), lane = tid & 63, w = tid >> 6;
  const int n = ci & 31, bh = ci >> 5, b = bh / 6, h = bh % 6;
  const size_t tok0 = (size_t)b * SEQ + n * 64;
  const size_t cb = (size_t)ci * 4096;
  if (w == 0) {
    const size_t tok = tok0 + lane;
    const float beta = sigmoidf(p.BA[tok * 16 + h]);
    const float g = -expf(p.a_log[layer * 6 + h]) * softplus(p.BA[tok * 16 + 6 + h] + p.dt_bias[layer * 6 + h]);
    float c = g;
#pragma unroll
    for (int o = 1; o < 64; o <<= 1) { const float t = __shfl_up(c, o); if (lane >= o) c += t; }
    gcs[lane] = c; bts[lane] = beta; rsc[lane] = beta * expf(c);
  }
  __syncthreads();
  {
    const float* cw = p.conv_w + (size_t)layer * 4 * 1152;
    unsigned rw0[19], rw1[19], rw2[19];
#define CONV_ISSUE(dst_, sec_)                                                                        \
    _Pragma("unroll") for (int j = 0; j < 19; ++j) {                                                  \
      const int tl_ = n * 64 + w * 16 + j - 3;                                                        \
      const u16* ptr_ = p.P + ((size_t)b * SEQ + (tl_ >= 0 ? tl_ : 0)) * NP + (sec_) * 384 + h * 64 + lane; \
      asm volatile("global_load_ushort %0, %1, off" : "=v"(dst_[j]) : "v"(ptr_) : "memory");          \
    }
#define CONV_WAIT(d_)                                                                                 \
    asm volatile("s_waitcnt vmcnt(0)"                                                                 \
                 : "+v"(d_[0]), "+v"(d_[1]), "+v"(d_[2]), "+v"(d_[3]), "+v"(d_[4]), "+v"(d_[5]), "+v"(d_[6]),      \
                   "+v"(d_[7]), "+v"(d_[8]), "+v"(d_[9]), "+v"(d_[10]), "+v"(d_[11]), "+v"(d_[12]), "+v"(d_[13]),  \
                   "+v"(d_[14]), "+v"(d_[15]), "+v"(d_[16]), "+v"(d_[17]), "+v"(d_[18]) :: "memory");
    CONV_ISSUE(rw0, 0)
    CONV_ISSUE(rw1, 1)
    CONV_ISSUE(rw2, 2)
    CONV_WAIT(rw0)
    CONV_WAIT(rw1)
    CONV_WAIT(rw2)
#undef CONV_ISSUE
#undef CONV_WAIT
#pragma unroll
    for (int sec = 0; sec < 3; ++sec) {
      const int col = sec * 384 + h * 64 + lane;
      float wt[4];
#pragma unroll
      for (int j = 0; j < 4; ++j) wt[j] = cw[j * 1152 + col];
      float xr[19];
#pragma unroll
      for (int j = 0; j < 19; ++j) {
        const int tl = n * 64 + w * 16 + j - 3;
        const unsigned rv = sec == 0 ? rw0[j] : (sec == 1 ? rw1[j] : rw2[j]);
        xr[j] = tl >= 0 ? __uint_as_float(rv << 16) : 0.f;
      }
      float* dst = sec == 0 ? Am : (sec == 1 ? Kf : Vf);
      const int dld = sec == 0 ? 68 : 65;
#pragma unroll
      for (int i = 0; i < 16; ++i) {
        float v = wt[0] * xr[i] + wt[1] * xr[i + 1] + wt[2] * xr[i + 2] + wt[3] * xr[i + 3];
        dst[(w * 16 + i) * dld + lane] = silu(v);
      }
    }
  }
  __syncthreads();
  {
    const int ti = tid >> 2, qd = tid & 3;
    float qv[16], kv[16];
    float sq = 0.f, sk = 0.f;
#pragma unroll
    for (int e = 0; e < 16; ++e) {
      qv[e] = Am[ti * 68 + qd * 16 + e]; kv[e] = Kf[ti * 65 + qd * 16 + e];
      sq += qv[e] * qv[e]; sk += kv[e] * kv[e];
    }
    sq += __shfl_xor(sq, 1); sq += __shfl_xor(sq, 2);
    sk += __shfl_xor(sk, 1); sk += __shfl_xor(sk, 2);
    const float rq = rsqrtf(sq + 1e-6f) * 0.125f, rk = rsqrtf(sk + 1e-6f);
    const float eg = fexp(gcs[ti]);
    unsigned qg[8];
#pragma unroll
    for (int e = 0; e < 16; e += 2) {
      const float q0 = qv[e] * rq, q1 = qv[e + 1] * rq, k0 = kv[e] * rk, k1 = kv[e + 1] * rk;
      *(unsigned*)(Qs + ti * 72 + qd * 16 + e) = pk2(q0, q1);
      *(unsigned*)(Ks + ti * 72 + qd * 16 + e) = pk2(k0, k1);
      Kf[ti * 65 + qd * 16 + e] = k0; Kf[ti * 65 + qd * 16 + e + 1] = k1;
      qg[e >> 1] = pk2(q0 * eg, q1 * eg);
    }
    uint4* gq = (uint4*)(p.gQG + cb + ti * 64 + qd * 16);
    gq[0] = make_uint4(qg[0], qg[1], qg[2], qg[3]);
    gq[1] = make_uint4(qg[4], qg[5], qg[6], qg[7]);
  }
  __syncthreads();
  {
    const int fr = lane & 15, fq = lane >> 4;
    bf16x8 ak[2], aq[2];
#pragma unroll
    for (int ks = 0; ks < 2; ++ks) {
      ak[ks] = *(const bf16x8*)(Ks + (16 * w + fr) * 72 + ks * 32 + fq * 8);
      aq[ks] = *(const bf16x8*)(Qs + (16 * w + fr) * 72 + ks * 32 + fq * 8);
    }
#pragma unroll
    for (int nn = 0; nn < 4; ++nn) {
      f32x4 cA = {0.f, 0.f, 0.f, 0.f}, cQ = {0.f, 0.f, 0.f, 0.f};
#pragma unroll
      for (int ks = 0; ks < 2; ++ks) {
        const bf16x8 bk = *(const bf16x8*)(Ks + (16 * nn + fr) * 72 + ks * 32 + fq * 8);
        cA = __builtin_amdgcn_mfma_f32_16x16x32_bf16(ak[ks], bk, cA, 0, 0, 0);
        cQ = __builtin_amdgcn_mfma_f32_16x16x32_bf16(aq[ks], bk, cQ, 0, 0, 0);
      }
#pragma unroll
      for (int j = 0; j < 4; ++j) {
        const int i = 16 * w + 4 * fq + j, jj = 16 * nn + fr;
        const float dec = (i >= jj) ? fexp(gcs[i] - gcs[jj]) : 0.f;
        Am[i * 68 + jj] = (i > jj) ? bts[i] * cA[j] * dec : 0.f;
        p.gQK[cb + i * 64 + jj] = f2bf(cQ[j] * dec);
      }
    }
  }
  __syncthreads();
  if (tid < 128) {
    const int c = tid & 63;
    const bool isw = tid >= 64;
    const float* X = isw ? Kf : Vf;
    const float* sc = isw ? rsc : bts;
    float x[64];
#pragma unroll
    for (int i = 0; i < 64; ++i) {
      float acc = sc[i] * X[i * 65 + c];
#pragma unroll
      for (int j = 0; j < i; ++j) acc -= Am[i * 68 + j] * x[j];
      x[i] = acc;
      if (isw) p.gW[cb + i * 64 + c] = f2bf(-acc);
      else p.gU[cb + i * 64 + c] = acc;
      asm volatile("" ::: "memory");
    }
  } else {
    const float e = fexp(gcs[63] - gcs[lane]);
    for (int d = 0; d < 32; ++d) {
      const int dk = (w - 2) * 32 + d;
      p.gKGt[cb + dk * 64 + lane] = f2bf(Kf[lane * 65 + dk] * e);
    }
    if (tid == 128) p.gGL[ci] = expf(gcs[63]);
  }
  __syncthreads();
}

__device__ void gdn_rec(const Params& p, int layer, int bh, char* smem) {
  u16* sM = (u16*)smem;
  u16* sZ = sM + 4 * 64 * 72;
  float* part = (float*)(sZ + 64 * 72);
  const int tid = otid(), lane = tid & 63, w = tid >> 6, fr = lane & 15, fq = lane >> 4;
  const int b = bh / 6, h = bh % 6;
  f32x4 S[4];
#pragma unroll
  for (int m = 0; m < 4; ++m) S[m] = f32x4{0.f, 0.f, 0.f, 0.f};
  const float gw = p.gdn_norm_w[layer * 64 + 16 * w + fr];
  const int srow = tid >> 3, sch = tid & 7;
  uint4 A0, A1, A2, A3, A4, A5, A6, A7, A8, A9, B0, B1, B2, B3, B4, B5, B6, B7, B8, B9;
  f32x4 Au[4], Bu[4], uc[4];
  float Agl, Bgl, glc;
#define GDN_LOAD(S_, nn_)                                                                     \
  {                                                                                           \
    const size_t cb_ = ((size_t)bh * 32 + (nn_)) * 4096;                                      \
    const size_t o0_ = cb_ + srow * 64 + sch * 8, o1_ = o0_ + 32 * 64;                        \
    S_##0 = *(const uint4*)(p.gW + o0_);   S_##1 = *(const uint4*)(p.gW + o1_);               \
    S_##2 = *(const uint4*)(p.gQG + o0_);  S_##3 = *(const uint4*)(p.gQG + o1_);              \
    S_##4 = *(const uint4*)(p.gQK + o0_);  S_##5 = *(const uint4*)(p.gQK + o1_);              \
    S_##6 = *(const uint4*)(p.gKGt + o0_); S_##7 = *(const uint4*)(p.gKGt + o1_);             \
    const u16* zp_ = p.P + ((size_t)b * SEQ + (nn_) * 64 + srow) * NP + ZA + h * 64 + sch * 8; \
    S_##8 = *(const uint4*)(zp_);          S_##9 = *(const uint4*)(zp_ + (size_t)32 * NP);    \
    _Pragma("unroll") for (int m = 0; m < 4; ++m)                                             \
      _Pragma("unroll") for (int j = 0; j < 4; ++j)                                           \
        S_##u[m][j] = p.gU[cb_ + (16 * m + 4 * fq + j) * 64 + 16 * w + fr];                   \
    S_##gl = p.gGL[bh * 32 + (nn_)];                                                          \
  }
#define GDN_STASH(S_)                                                                         \
  {                                                                                           \
    u16* d0_ = sM + srow * 72 + sch * 8;                                                      \
    u16* d1_ = d0_ + 32 * 72;                                                                 \
    *(uint4*)(d0_) = S_##0;               *(uint4*)(d1_) = S_##1;                             \
    *(uint4*)(d0_ + 64 * 72) = S_##2;     *(uint4*)(d1_ + 64 * 72) = S_##3;                   \
    *(uint4*)(d0_ + 2 * 64 * 72) = S_##4; *(uint4*)(d1_ + 2 * 64 * 72) = S_##5;               \
    *(uint4*)(d0_ + 3 * 64 * 72) = S_##6; *(uint4*)(d1_ + 3 * 64 * 72) = S_##7;               \
    *(uint4*)(d0_ + 4 * 64 * 72) = S_##8; *(uint4*)(d1_ + 4 * 64 * 72) = S_##9;               \
    _Pragma("unroll") for (int m = 0; m < 4; ++m) uc[m] = S_##u[m];                           \
    glc = S_##gl;                                                                             \
  }
#define GDN_BODY(n_, NEXT_)                                                                   \
  {                                                                                           \
    bf16x8 Sb[2], Vb[2];                                                                      \
    Sb[0] = packB(S[0], S[1]);                                                                \
    Sb[1] = packB(S[2], S[3]);                                                                \
    f32x4 av[4];                                                                              \
    _Pragma("unroll") for (int m = 0; m < 4; ++m) {                                           \
      av[m] = uc[m];                                                                          \
      _Pragma("unroll") for (int ks = 0; ks < 2; ++ks)                                        \
        av[m] = __builtin_amdgcn_mfma_f32_16x16x32_bf16(ldfragP(sM, 72, 16 * m + fr, ks, fq), Sb[ks], av[m], 0, 0, 0); \
    }                                                                                         \
    Vb[0] = packB(av[0], av[1]);                                                              \
    Vb[1] = packB(av[2], av[3]);                                                              \
    f32x4 O[4];                                                                               \
    _Pragma("unroll") for (int m = 0; m < 4; ++m) {                                           \
      f32x4 o = {0.f, 0.f, 0.f, 0.f};                                                         \
      _Pragma("unroll") for (int ks = 0; ks < 2; ++ks) {                                      \
        o = __builtin_amdgcn_mfma_f32_16x16x32_bf16(ldfragP(sM + 64 * 72, 72, 16 * m + fr, ks, fq), Sb[ks], o, 0, 0, 0);     \
        o = __builtin_amdgcn_mfma_f32_16x16x32_bf16(ldfragP(sM + 2 * 64 * 72, 72, 16 * m + fr, ks, fq), Vb[ks], o, 0, 0, 0); \
      }                                                                                       \
      O[m] = o;                                                                               \
    }                                                                                         \
    _Pragma("unroll") for (int m = 0; m < 4; ++m) {                                           \
      f32x4 sacc = S[m] * glc;                                                                \
      _Pragma("unroll") for (int ks = 0; ks < 2; ++ks)                                        \
        sacc = __builtin_amdgcn_mfma_f32_16x16x32_bf16(ldfragP(sM + 3 * 64 * 72, 72, 16 * m + fr, ks, fq), Vb[ks], sacc, 0, 0, 0); \
      S[m] = sacc;                                                                            \
    }                                                                                         \
    f32x4 zc[4];                                                                              \
    _Pragma("unroll") for (int m = 0; m < 4; ++m)                                             \
      _Pragma("unroll") for (int j = 0; j < 4; ++j)                                           \
        zc[m][j] = bf2f(sZ[(16 * m + 4 * fq + j) * 72 + 16 * w + fr]);                        \
    _Pragma("unroll") for (int hh = 0; hh < 2; ++hh) {                                        \
      f32x4 sq0 = O[2 * hh] * O[2 * hh], sq1 = O[2 * hh + 1] * O[2 * hh + 1];                 \
      _Pragma("unroll") for (int msk = 1; msk < 16; msk <<= 1) {                              \
        _Pragma("unroll") for (int j = 0; j < 4; ++j) {                                       \
          sq0[j] += __shfl_xor(sq0[j], msk); sq1[j] += __shfl_xor(sq1[j], msk);               \
        }                                                                                     \
      }                                                                                       \
      if (fr == 0) {                                                                          \
        *(f32x4*)(part + w * 64 + 16 * (2 * hh) + 4 * fq) = sq0;                              \
        *(f32x4*)(part + w * 64 + 16 * (2 * hh + 1) + 4 * fq) = sq1;                          \
      }                                                                                       \
    }                                                                                         \
    __syncthreads();                                                                          \
    GDN_STASH(NEXT_);                                                                         \
    _Pragma("unroll") for (int m = 0; m < 4; ++m)                                             \
      _Pragma("unroll") for (int j = 0; j < 4; ++j) {                                         \
        const int row = 16 * m + 4 * fq + j;                                                  \
        const float tot = (part[row] + part[64 + row]) + (part[128 + row] + part[192 + row]); \
        const float rr = rsqrtf(tot * (1.f / 64.f) + 1e-6f);                                  \
        const size_t tok = (size_t)b * SEQ + (n_) * 64 + row;                                 \
        const int col = h * 64 + 16 * w + fr;                                                 \
        p.mixed[tok * MLD + col] = f2bf(O[m][j] * rr * gw * silu(zc[m][j]));                  \
      }                                                                                       \
    __syncthreads();                                                                          \
  }
  __syncthreads();
  __builtin_amdgcn_s_setprio(3);
  GDN_LOAD(A, 0);
  GDN_LOAD(B, 1);
  GDN_STASH(A);
  __syncthreads();
  for (int n = 0; n < 32; n += 2) {
    { const int n2 = n + 2 < 32 ? n + 2 : 31; GDN_LOAD(A, n2); }
    GDN_BODY(n, B);
    { const int n3 = n + 3 < 32 ? n + 3 : 31; GDN_LOAD(B, n3); }
    GDN_BODY(n + 1, A);
  }
  __builtin_amdgcn_s_setprio(0);
#undef GDN_LOAD
#undef GDN_STASH
#undef GDN_BODY
}

typedef short s16x4 __attribute__((ext_vector_type(4)));
DI s16x4 tr_read(const u16* lds_ptr) {
  return __builtin_amdgcn_ds_read_tr16_b64_v4i16((__attribute__((address_space(3))) s16x4*)(lds_ptr));
}
DI bf16x8 vt_frag(const u16* sV, int key0, int mm, int lane) {
  const int fq = lane >> 4, q = (lane & 15) >> 2, pp = lane & 3;
  const u16* a = sV + (key0 + 4 * fq + q) * 72 + 16 * mm + 4 * pp;
  const s16x4 lo = tr_read(a), hi = tr_read(a + 16 * 72);
  return __builtin_shufflevector(lo, hi, 0, 1, 2, 3, 4, 5, 6, 7);
}

__device__ void sb_mfma(const Params& p, int unit, char* smem) {
  u16* sK = (u16*)smem;
  u16* sV = sK + 2 * 64 * 72;
  const int tid = otid(), lane = tid & 63, w = tid >> 6, fr = lane & 15, fq = lane >> 4;
  const int bh = unit & 63, qb = 31 - (unit >> 6), b = bh >> 2, h = bh & 3;
  const int t0 = qb * 64;
  const int tq = t0 + 16 * w + fr;
  const size_t tokq = (size_t)b * SEQ + tq;
  bf16x8 qf[2];
#pragma unroll
  for (int ks = 0; ks < 2; ++ks) qf[ks] = *(const bf16x8*)(p.P + tokq * NP + QB + h * 64 + 32 * ks + 8 * fq);
  f32x4 ot[4];
#pragma unroll
  for (int mm = 0; mm < 4; ++mm) ot[mm] = f32x4{0.f, 0.f, 0.f, 0.f};
  const u16* zp_ = p.P + tokq * NP + ZB + h * 64 + 4 * fq;
  const uint2 zq0 = *(const uint2*)(zp_), zq1 = *(const uint2*)(zp_ + 16), zq2 = *(const uint2*)(zp_ + 32), zq3 = *(const uint2*)(zp_ + 48);
  __builtin_amdgcn_sched_barrier(0);
  float R = 0.f;
  const float csc = 0.125f * 1.44269504088896f;
  const int lrow = tid >> 3, lch = tid & 7;
  const u16* gk = p.P + ((size_t)b * SEQ + lrow) * NP + KB + h * 64 + lch * 8;
  const u16* gv = p.P + ((size_t)b * SEQ + lrow) * NP + VB + h * 64 + lch * 8;
  uint4 rk0, rk1, rv0, rv1;
  __syncthreads();
  rk0 = *(const uint4*)(gk + (size_t)(qb * 64) * NP);
  rk1 = *(const uint4*)(gk + (size_t)(qb * 64 + 32) * NP);
  rv0 = *(const uint4*)(gv + (size_t)(qb * 64) * NP);
  rv1 = *(const uint4*)(gv + (size_t)(qb * 64 + 32) * NP);
  *(uint4*)(sK + lrow * 72 + lch * 8) = rk0;
  *(uint4*)(sK + (lrow + 32) * 72 + lch * 8) = rk1;
  *(uint4*)(sV + lrow * 72 + lch * 8) = rv0;
  *(uint4*)(sV + (lrow + 32) * 72 + lch * 8) = rv1;
  __syncthreads();
  int cur = 0;
  for (int kt = qb; kt >= 0; --kt) {
    {
      const int kn = kt > 0 ? kt - 1 : 0;
      rk0 = *(const uint4*)(gk + (size_t)(kn * 64) * NP);
      rk1 = *(const uint4*)(gk + (size_t)(kn * 64 + 32) * NP);
      rv0 = *(const uint4*)(gv + (size_t)(kn * 64) * NP);
      rv1 = *(const uint4*)(gv + (size_t)(kn * 64 + 32) * NP);
    }
    __builtin_amdgcn_sched_barrier(0);
    const u16* cK = sK + cur * 64 * 72;
    const u16* cV = sV + cur * 64 * 72;
    f32x4 st[4];
#pragma unroll
    for (int m = 0; m < 4; ++m) {
      st[m] = f32x4{0.f, 0.f, 0.f, 0.f};
#pragma unroll
      for (int ks = 0; ks < 2; ++ks)
        st[m] = __builtin_amdgcn_mfma_f32_16x16x32_bf16(*(const bf16x8*)(cK + (16 * m + fr) * 72 + 32 * ks + 8 * fq), qf[ks], st[m], 0, 0, 0);
    }
    float lk[4][4], lb[4][4], G[4], T[4], E[4];
#pragma unroll
    for (int m = 0; m < 4; ++m) {
#pragma unroll
      for (int j = 0; j < 4; ++j) {
        const float z2 = st[m][j] * csc;
        const float sp = fmaxf(z2, 0.f) + lg2(1.f + ex2(-fabsf(z2)));
        const bool valid = kt != qb || (kt * 64 + 16 * m + 4 * fq + j) < tq;
        lk[m][j] = valid ? -sp : 0.f;
        lb[m][j] = valid ? z2 - sp : -1e30f;
      }
      G[m] = (lk[m][0] + lk[m][1]) + (lk[m][2] + lk[m][3]);
    }
#pragma unroll
    for (int m = 0; m < 4; ++m) {
      const float a = __shfl_xor(G[m], 16);
      const float s1 = G[m] + a;
      const float c2 = __shfl_xor(s1, 32);
      T[m] = s1 + c2;
      E[m] = fq == 0 ? (a + c2) : (fq == 1 ? c2 : (fq == 2 ? a : 0.f));
    }
    float base = R;
    f32x4 wt[4];
#pragma unroll
    for (int m = 3; m >= 0; --m) {
      float e = base + E[m];
#pragma unroll
      for (int j = 3; j >= 0; --j) {
        wt[m][j] = ex2(lb[m][j] + e);
        e += lk[m][j];
      }
      base += T[m];
    }
    R = base;
    bf16x8 pb[2];
    pb[0] = packB(wt[0], wt[1]);
    pb[1] = packB(wt[2], wt[3]);
#pragma unroll
    for (int mm = 0; mm < 4; ++mm)
#pragma unroll
      for (int k2 = 0; k2 < 2; ++k2)
        ot[mm] = __builtin_amdgcn_mfma_f32_16x16x32_bf16(vt_frag(cV, 32 * k2, mm, lane), pb[k2], ot[mm], 0, 0, 0);
    {
      u16* nK = sK + (cur ^ 1) * 64 * 72;
      u16* nV = sV + (cur ^ 1) * 64 * 72;
      *(uint4*)(nK + lrow * 72 + lch * 8) = rk0;
      *(uint4*)(nK + (lrow + 32) * 72 + lch * 8) = rk1;
      *(uint4*)(nV + lrow * 72 + lch * 8) = rv0;
      *(uint4*)(nV + (lrow + 32) * 72 + lch * 8) = rv1;
    }
    __syncthreads();
    cur ^= 1;
  }
#pragma unroll
  for (int mm = 0; mm < 4; ++mm) {
    const int dh = 16 * mm + 4 * fq;
    const uint2 zr = mm == 0 ? zq0 : (mm == 1 ? zq1 : (mm == 2 ? zq2 : zq3));
    const unsigned zx = zr.x, zy = zr.y;
    const float z0 = __uint_as_float(zx << 16), z1 = __uint_as_float(zx & 0xffff0000u);
    const float z2 = __uint_as_float(zy << 16), z3 = __uint_as_float(zy & 0xffff0000u);
    uint2 o;
    o.x = pk2(ot[mm][0] * silu(z0), ot[mm][1] * silu(z1));
    o.y = pk2(ot[mm][2] * silu(z2), ot[mm][3] * silu(z3));
    *(uint2*)(p.mixed + tokq * MLD + 384 + h * 64 + dh) = o;
  }
}

__device__ void dil_mfma(const Params& p, int unit, char* smem) {
  const int tid = otid(), lane = tid & 63, w = tid >> 6, fr = lane & 15, fq = lane >> 4;
  u16* sV = (u16*)smem + w * (32 * 72);
  const int rq = unit & 3, a = (unit >> 2) & 7, bh = unit >> 5, b = bh / 6, h = bh % 6;
  const int r = 4 * rq + w;
  const int tq = r + 16 * (16 * a + fr);
  const size_t tokq = (size_t)b * SEQ + tq;
  bf16x8 qf[2];
#pragma unroll
  for (int ks = 0; ks < 2; ++ks) qf[ks] = *(const bf16x8*)(p.P + tokq * NP + QC + h * 64 + 32 * ks + 8 * fq);
  f32x4 ot[4];
#pragma unroll
  for (int mm = 0; mm < 4; ++mm) ot[mm] = f32x4{0.f, 0.f, 0.f, 0.f};
  float Ls = 0.f;
  const u16* zp_ = p.P + tokq * NP + ZC + h * 64 + 4 * fq;
  const uint2 zq0 = *(const uint2*)(zp_), zq1 = *(const uint2*)(zp_ + 16), zq2 = *(const uint2*)(zp_ + 32), zq3 = *(const uint2*)(zp_ + 48);
  __builtin_amdgcn_sched_barrier(0);
  const float csc = 0.125f * 1.44269504088896f;
  const u16* kbase = p.P + (size_t)b * SEQ * NP + KC + h * 64;
  const u16* vbase = p.P + (size_t)b * SEQ * NP + VC + h * 64;
  int g = 0, stp = 0;
  int d = 1, rr = 0, lo = r + 256 * a - 128, nsteps = 12, iq = r + 256 * a + 16 * fr, imax = SEQ - 1;
  bf16x8 k00, k01, k10, k11;
  uint4 v0, v1, v2, v3;
#define DIL_LOAD(d_, rr_, i0_, imax_)                                                            \
  {                                                                                              \
    const int ib_ = (i0_) + (lane >> 3);                                                         \
    const u16* vb_ = vbase + (lane & 7) * 8;                                                     \
    v0 = *(const uint4*)(vb_ + (size_t)((rr_) + (d_) * min(max(ib_, 0), (imax_))) * NP);         \
    v1 = *(const uint4*)(vb_ + (size_t)((rr_) + (d_) * min(max(ib_ + 8, 0), (imax_))) * NP);     \
    v2 = *(const uint4*)(vb_ + (size_t)((rr_) + (d_) * min(max(ib_ + 16, 0), (imax_))) * NP);    \
    v3 = *(const uint4*)(vb_ + (size_t)((rr_) + (d_) * min(max(ib_ + 24, 0), (imax_))) * NP);    \
    const u16* ka_ = kbase + (size_t)((rr_) + (d_) * min(max((i0_) + fr, 0), (imax_))) * NP + 8 * fq;       \
    const u16* kb_ = kbase + (size_t)((rr_) + (d_) * min(max((i0_) + 16 + fr, 0), (imax_))) * NP + 8 * fq;  \
    k00 = *(const bf16x8*)(ka_); k01 = *(const bf16x8*)(ka_ + 32);                               \
    k10 = *(const bf16x8*)(kb_); k11 = *(const bf16x8*)(kb_ + 32);                               \
  }
  DIL_LOAD(d, rr, lo, imax);
  while (g < 3) {
    const bf16x8 c00 = k00, c01 = k01, c10 = k10, c11 = k11;
    const uint4 w0 = v0, w1 = v1, w2 = v2, w3 = v3;
    const int i0 = lo + 32 * stp, iqc = iq;
    int ng = g, nstp = stp + 1;
    if (nstp >= nsteps) { ng = g + 1; nstp = 0; }
    if (ng != g) {
      if (ng == 1) { d = 4; rr = r & 3; lo = (r >> 2) + 64 * a - 128; nsteps = 6; iq = (r >> 2) + 64 * a + 4 * fr; imax = SEQ / 4 - 1; }
      else { d = 16; rr = r; lo = 0; nsteps = (a + 2) >> 1; iq = 16 * a + fr; imax = SEQ / 16 - 1; }
    }
    g = ng; stp = nstp;
    DIL_LOAD(d, rr, lo + 32 * stp, imax);
    __builtin_amdgcn_sched_barrier(0);
    f32x4 st0 = {0.f, 0.f, 0.f, 0.f}, st1 = {0.f, 0.f, 0.f, 0.f};
    st0 = __builtin_amdgcn_mfma_f32_16x16x32_bf16(c00, qf[0], st0, 0, 0, 0);
    st0 = __builtin_amdgcn_mfma_f32_16x16x32_bf16(c01, qf[1], st0, 0, 0, 0);
    st1 = __builtin_amdgcn_mfma_f32_16x16x32_bf16(c10, qf[0], st1, 0, 0, 0);
    st1 = __builtin_amdgcn_mfma_f32_16x16x32_bf16(c11, qf[1], st1, 0, 0, 0);
    {
      u16* dv = sV + (lane >> 3) * 72 + (lane & 7) * 8;
      *(uint4*)(dv) = w0; *(uint4*)(dv + 8 * 72) = w1; *(uint4*)(dv + 16 * 72) = w2; *(uint4*)(dv + 24 * 72) = w3;
    }
    f32x4 wt0, wt1;
    const int vlo = iqc - 128 > 0 ? iqc - 128 : 0;
    const unsigned vspan = (unsigned)(iqc - vlo);
    const int vb = i0 + 4 * fq - vlo;
#pragma unroll
    for (int j = 0; j < 4; ++j) {
      const unsigned d0 = (unsigned)(vb + j), d1 = d0 + 16u;
      const float e0 = d0 <= vspan ? ex2(st0[j] * csc) : 0.f;
      const float e1 = d1 <= vspan ? ex2(st1[j] * csc) : 0.f;
      wt0[j] = e0; wt1[j] = e1;
      Ls += e0 + e1;
    }
    const bf16x8 pb = packB(wt0, wt1);
#pragma unroll
    for (int mm = 0; mm < 4; ++mm)
      ot[mm] = __builtin_amdgcn_mfma_f32_16x16x32_bf16(vt_frag(sV, 0, mm, lane), pb, ot[mm], 0, 0, 0);
  }
#undef DIL_LOAD
  Ls += __shfl_xor(Ls, 16);
  Ls += __shfl_xor(Ls, 32);
  const float il = 1.f / Ls;
#pragma unroll
  for (int mm = 0; mm < 4; ++mm) {
    const int dh = 16 * mm + 4 * fq;
    const uint2 zr = mm == 0 ? zq0 : (mm == 1 ? zq1 : (mm == 2 ? zq2 : zq3));
    const unsigned zx = zr.x, zy = zr.y;
    const float z0 = __uint_as_float(zx << 16), z1 = __uint_as_float(zx & 0xffff0000u);
    const float z2 = __uint_as_float(zy << 16), z3 = __uint_as_float(zy & 0xffff0000u);
    uint2 o;
    o.x = pk2(ot[mm][0] * il * silu(z0), ot[mm][1] * il * silu(z1));
    o.y = pk2(ot[mm][2] * il * silu(z2), ot[mm][3] * il * silu(z3));
    *(uint2*)(p.mixed + tokq * MLD + 640 + h * 64 + dh) = o;
  }
}

__device__ void phase_mix(const Params& p, int layer, char* smem, int bid, int nblk) {
  const int nG = 96, nS = 64 * 32, nD = 96 * 32;
  __shared__ int s_unit;
  for (;;) {
    __syncthreads();
    if (otid() == 0) s_unit = atomicAdd(p.ctr + layer, 1);
    __syncthreads();
    const int u = s_unit;
    if (u >= nG + nS + nD) break;
    if (u < nG) gdn_rec(p, layer, u, smem);
    else if (u < nG + nS) sb_mfma(p, u - nG, smem);
    else dil_mfma(p, u - nG - nS, smem);
  }
}


#define XB_TMO      128
#define XB_XCNT(j)  (256  + 64 * (j))
#define XB_XSUB(j)  (1280 + 64 * (j))
#define XB_XGEN(j)  (2304 + 64 * (j))
#define XB_TOP      3328
#define XB_TOPGEN   3392
#define XCD_BAR_WORDS 3456
#define XB_SPIN_CAP (1u << 20)
#define LAS __attribute__((address_space(3)))
DI unsigned xb_ld(unsigned* p) { return __hip_atomic_load(p, __ATOMIC_RELAXED, __HIP_MEMORY_SCOPE_AGENT); }
DI unsigned xb_add(unsigned* p, unsigned v) { return __hip_atomic_fetch_add(p, v, __ATOMIC_RELAXED, __HIP_MEMORY_SCOPE_AGENT); }
DI unsigned xb_xcc_id() { return (unsigned)__builtin_amdgcn_s_getreg((3 << 11) | 20) & 0xFu; }
#define XB_SPIN(cond, bar) do { unsigned _sp = 0; while (cond) { __builtin_amdgcn_s_sleep(1); \
    if ((++_sp & 255u) == 0u) { if (xb_ld(&(bar)[XB_TMO])) break; if (_sp > XB_SPIN_CAP) { atomicAdd(&(bar)[XB_TMO], 1u); break; } } } } while (0)
struct XcdBarrier { unsigned* bar; unsigned x; volatile LAS unsigned* st; };
DI XcdBarrier xcd_barrier_post(unsigned* bar, volatile LAS unsigned* st) {
  XcdBarrier b; b.bar = bar; b.x = xb_xcc_id(); b.st = st;
  if (threadIdx.x == 0) (void)xb_add(&bar[XB_XCNT(b.x)], 1u);
  return b;
}
DI void xcd_barrier_complete(unsigned* bar, unsigned x, unsigned& nloc, unsigned& nx) {
  const unsigned G = gridDim.x * gridDim.y * gridDim.z;
  unsigned sum, cnt, mine, sp = 0u;
  for (;;) {
    sum = 0u; cnt = 0u; mine = 0u;
#pragma unroll
    for (unsigned j = 0; j < 16; ++j) { const unsigned c = xb_ld(&bar[XB_XCNT(j)]); sum += c; cnt += (c > 0u) ? 1u : 0u; mine = (j == x) ? c : mine; }
    if (sum == G) break;
    __builtin_amdgcn_s_sleep(1);
    if ((++sp & 255u) == 0u) { if (xb_ld(&bar[XB_TMO])) break; if (sp > XB_SPIN_CAP) { atomicAdd(&bar[XB_TMO], 1u); break; } }
  }
  nloc = mine > 0u ? mine : 1u; nx = cnt > 0u ? cnt : 1u;
}
DI void xcd_barrier(const XcdBarrier& b) {
  asm volatile("s_waitcnt vmcnt(0)" ::: "memory");
  __syncthreads();
  if (threadIdx.x == 0) {
    unsigned* bar = b.bar;
    __builtin_amdgcn_s_waitcnt(0);
    unsigned nloc = b.st[0], nx = b.st[1];
    if (nloc == 0u) { xcd_barrier_complete(bar, b.x, nloc, nx); b.st[0] = nloc; b.st[1] = nx; }
    const unsigned old = xb_add(&bar[XB_XSUB(b.x)], 1u);
    const unsigned gen = old / nloc;
    if (old + 1u == (gen + 1u) * nloc) {
      __builtin_amdgcn_fence(__ATOMIC_RELEASE, "agent");
      asm volatile("s_waitcnt vmcnt(0)" ::: "memory");
      const unsigned og = xb_add(&bar[XB_TOP], 1u);
      const unsigned tg = og / nx;
      if (og + 1u == (tg + 1u) * nx) xb_add(&bar[XB_TOPGEN], 1u);
      else XB_SPIN(xb_ld(&bar[XB_TOPGEN]) == tg, bar);
      __builtin_amdgcn_fence(__ATOMIC_ACQUIRE, "agent");
      xb_add(&bar[XB_XGEN(b.x)], 1u);
      asm volatile("s_waitcnt vmcnt(0)" ::: "memory");
    } else {
      XB_SPIN(xb_ld(&bar[XB_XGEN(b.x)]) == gen, bar);
      __builtin_amdgcn_fence(__ATOMIC_ACQUIRE, "agent");
      asm volatile("s_waitcnt vmcnt(0)" ::: "memory");
    }
  }
  __syncthreads();
}

constexpr int SMEM_BYTES = 70144;

__global__ void __launch_bounds__(256, 2) mega(Params p, int ph_lo, int ph_hi) {
  __shared__ __attribute__((aligned(16))) char smem[SMEM_BYTES];
  const int bid = blockIdx.x, nblk = gridDim.x;
  __shared__ uint4 xb_words;
  if (threadIdx.x == 0) xb_words = make_uint4(0u, 0u, 0u, 0u);
  __syncthreads();
  const XcdBarrier xb = xcd_barrier_post(p.bar, (volatile LAS unsigned*)&xb_words);
  if (ph_hi < 0) cg::this_grid().sync();
  for (int ph = ph_lo; ph < ph_hi; ++ph) {
    if (ph > ph_lo) {
      xcd_barrier(xb);
    }
    if (ph == 0) { phase_prep(p, (float*)smem, bid, nblk); continue; }
    const int layer = (ph - 1) / 4, sub = (ph - 1) % 4;
    if (sub == 0) { for (int r = 0; r < REP_IN; ++r) phase_inproj(p, layer, smem, bid, nblk); }
    else if (sub == 1) phase_qknorm(p, layer, smem, bid, nblk);
    else if (sub == 2) { for (int r = 0; r < REP_MIX; ++r) phase_mix(p, layer, smem, bid, nblk); }
    else phase_outproj(p, layer, smem, bid, nblk);
  }
}

extern "C" void kernel_launch(void* const* d_in, const int* in_sizes, int n_in, void* d_out, int out_size,
                              void* d_ws, size_t ws_size, hipStream_t stream) {
  Params p{};
  p.x = (const float*)d_in[0]; p.norm_w = (const float*)d_in[1]; p.w_in = (const float*)d_in[2];
  p.conv_w = (const float*)d_in[3]; p.a_log = (const float*)d_in[4]; p.dt_bias = (const float*)d_in[5];
  p.gdn_norm_w = (const float*)d_in[6]; p.q_norm_w = (const float*)d_in[7]; p.k_norm_w = (const float*)d_in[8];
  p.w_out = (const float*)d_in[9];
  p.out = (float*)d_out;
  char* ws = (char*)d_ws;
  size_t off = 0;
  auto take = [&](size_t bytes) { char* r = ws + off; off += (bytes + 255) & ~(size_t)255; return r; };
  p.WinT = (u16*)take((size_t)2 * NPAD * DM * 2);
  p.WoutT = (u16*)take((size_t)2 * DM * DM * 2);
  p.P = (u16*)take((size_t)NTOK * NP * 2);
  p.BA = (float*)take((size_t)NTOK * 16 * 4);
  p.mixed = p.P;
  p.xb = (u16*)take((size_t)NTOK * DM * 2);
  const size_t nch = (size_t)96 * 32 * 4096;
  p.gU = (float*)take(nch * 4);
  p.gW = (u16*)take(nch * 2);
  p.gQK = (u16*)take(nch * 2);
  p.gQG = (u16*)take(nch * 2);
  p.gKGt = (u16*)take(nch * 2);
  p.gGL = (float*)take((size_t)96 * 32 * 4);
  p.ropeT = (float*)take((size_t)SEQ * 8 * 2 * 4);
  p.ctr = (int*)take(256);
  p.bar = (unsigned*)take((size_t)XCD_BAR_WORDS * 4);
  static int grid_blocks = 0;
  if (!grid_blocks) {
    int dev = 0, cus = 0, per_cu = 0;
    hipGetDevice(&dev);
    hipDeviceGetAttribute(&cus, hipDeviceAttributeMultiprocessorCount, dev);
    hipOccupancyMaxActiveBlocksPerMultiprocessor(&per_cu, mega, 256, 0);
    if (per_cu < 1) per_cu = 1;
    if (per_cu > 2) per_cu = 2;
    grid_blocks = cus * per_cu;
  }
  hipMemsetAsync(p.bar, 0, (size_t)XCD_BAR_WORDS * 4, stream);
#if COOP
  int lo = 0, hi = 9;
  void* args[] = {&p, &lo, &hi};
  hipError_t e = hipLaunchCooperativeKernel((void*)mega, dim3(grid_blocks), dim3(256), args, 0, stream);
  if (e != hipSuccess) fprintf(stderr, "cooperative launch failed: %s (grid %d)\n", hipGetErrorString(e), grid_blocks);
#else
  for (int ph = 0; ph < 9; ++ph) mega<<<grid_blocks, 256, 0, stream>>>(p, ph, ph + 1);
#endif
}
```

```cpp
#include <hip/hip_runtime.h>
#include <hip/hip_bf16.h>
#include <hip/hip_cooperative_groups.h>
#include <cstdio>
namespace cg = cooperative_groups;

typedef unsigned short u16;
using bf16x8 = __attribute__((ext_vector_type(8))) short;
using f32x4 = __attribute__((ext_vector_type(4))) float;
typedef __bf16 bf16x2_t __attribute__((ext_vector_type(2)));

#define DI __device__ __forceinline__

constexpr int NB = 16, SEQ = 2048, DM = 1024, NTOK = NB * SEQ;
constexpr int NP = 4096;
constexpr int NPAD = 4224;
constexpr int INC = 4108;
constexpr int MLD = NP;
constexpr int QA = 0, KA = 384, VA = 768, ZA = 1152, QB = 1536, KB = 1792, VB = 2048, ZB = 2304,
              QC = 2560, KC = 2944, VC = 3328, ZC = 3712;

#ifndef COOP
#define COOP 1
#endif
#define REP_IN 1
#define REP_MIX 1

struct Params {
  const float *x, *norm_w, *w_in, *conv_w, *a_log, *dt_bias, *gdn_norm_w, *q_norm_w, *k_norm_w, *w_out;
  float* out;
  u16 *WinT, *WoutT, *xb, *P, *mixed;
  float* BA;
  float *gU, *gGL, *ropeT;
  int* ctr;
  unsigned* bar;
  u16 *gW, *gQK, *gQG, *gKGt;
};

typedef float f32x2_t __attribute__((ext_vector_type(2)));
DI unsigned pk2(float lo, float hi) {
  const f32x2_t v = {lo, hi};
  return __builtin_bit_cast(unsigned, __builtin_convertvector(v, bf16x2_t));
}
DI u16 f2bf(float x) { return (u16)(pk2(x, 0.f) & 0xffffu); }
DI float bf2f(u16 h) { return __uint_as_float(((unsigned)h) << 16); }
DI float ex2(float x) { return __builtin_amdgcn_exp2f(x); }
DI float lg2(float x) { return __builtin_amdgcn_logf(x); }
DI float fexp(float x) { return ex2(x * 1.44269504088896f); }
DI float silu(float x) { return x * __builtin_amdgcn_rcpf(1.f + fexp(-x)); }
DI float softplus(float x) { return fmaxf(x, 0.f) + log1pf(expf(-fabsf(x))); }
DI float sigmoidf(float x) { return 1.f / (1.f + expf(-x)); }
DI int otid() { int t = threadIdx.x; asm volatile("" : "+v"(t)); return t; }
DI float wave_sum(float v) {
#pragma unroll
  for (int o = 32; o > 0; o >>= 1) v += __shfl_xor(v, o);
  return v;
}

DI int perm_col(int n) {
  if (n < 1536) return n;
  if (n < 4096) return n + 12;
  if (n < 4108) return 1536 + (n - 4096);
  return -1;
}

__device__ void phase_prep(const Params& p, float* smem, int bid, int nblk) {
  const int tid = otid();
  {
    const size_t n8 = (size_t)NTOK * DM / 8;
    for (size_t i = (size_t)bid * 256 + tid; i < n8; i += (size_t)nblk * 256) {
      const float4 a = ((const float4*)p.x)[2 * i], b = ((const float4*)p.x)[2 * i + 1];
      uint4 o;
      o.x = f2bf(a.x) | ((unsigned)f2bf(a.y) << 16);
      o.y = f2bf(a.z) | ((unsigned)f2bf(a.w) << 16);
      o.z = f2bf(b.x) | ((unsigned)f2bf(b.y) << 16);
      o.w = f2bf(b.z) | ((unsigned)f2bf(b.w) << 16);
      ((uint4*)p.xb)[i] = o;
    }
  }
  if (bid == 0 && tid < 8) p.ctr[tid] = 0;
  for (int i = bid * 256 + tid; i < SEQ * 8; i += nblk * 256) {
    const int t = i >> 3, f = i & 7;
    const float ang = (float)t * powf(500000.f, -(float)f / 8.f);
    p.ropeT[2 * i] = cosf(ang);
    p.ropeT[2 * i + 1] = sinf(ang);
  }
  const int nWin = 2 * (NPAD / 64) * 16, nWout = 2 * 16 * 16;
  float (*tile)[65] = (float (*)[65])smem;
  for (int u = bid; u < nWin + nWout; u += nblk) {
    const bool isin = u < nWin;
    int l, nt, kt;
    if (isin) { l = u / ((NPAD / 64) * 16); int r = u % ((NPAD / 64) * 16); nt = r / 16; kt = r % 16; }
    else { int v = u - nWin; l = v / 256; int r = v % 256; nt = r / 16; kt = r % 16; }
    const int tx = tid & 63, ty = tid >> 6;
    const int n = nt * 64 + tx;
    const int c = isin ? perm_col(n) : n;
    const float* src = isin ? p.w_in + (size_t)l * DM * INC : p.w_out + (size_t)l * DM * DM;
    const int ld = isin ? INC : DM;
    {
      const int cc = c >= 0 ? c : 0;
      const float msk = c >= 0 ? 1.f : 0.f;
      float wv[16], nwv[16];
#pragma unroll
      for (int i = 0; i < 16; ++i) {
        const int k = kt * 64 + ty + 4 * i;
        wv[i] = src[(size_t)k * ld + cc];
        nwv[i] = isin ? p.norm_w[l * DM + k] : 1.f;
      }
#pragma unroll
      for (int i = 0; i < 16; ++i) tile[ty + 4 * i][tx] = wv[i] * nwv[i] * msk;
    }
    __syncthreads();
    u16* dst = isin ? p.WinT + (size_t)l * NPAD * DM : p.WoutT + (size_t)l * DM * DM;
    for (int nn = ty; nn < 64; nn += 4)
      dst[(size_t)(nt * 64 + nn) * DM + kt * 64 + tx] = f2bf(tile[tx][nn]);
    __syncthreads();
  }
}

constexpr int LDT2 = 32;
template <int MODE>
__device__ void gemm_tile(const Params& p, const u16* __restrict__ A, const u16* __restrict__ Bt,
                          int mt, int nt, int layer, const float* resid, char* smem) {
  u16* sA = (u16*)smem;
  u16* sB = sA + 2 * 256 * LDT2;
  float* rs = (float*)(sB + 2 * 128 * LDT2);
  const int tid = otid(), lane = tid & 63, w = tid >> 6, wr = w >> 1, wc = w & 1;
  const int fr = lane & 15, fq = lane >> 4;
  const int lrow = tid >> 2, lch = tid & 3;
  const int wsw = lch ^ ((0x1320 >> (4 * ((lrow >> 2) & 3))) & 3);
  const int rsw = fq ^ ((0x1320 >> (4 * ((fr >> 2) & 3))) & 3);
  const size_t m0 = (size_t)mt * 256, n0 = (size_t)nt * 128;
  constexpr int K = DM, NK = K / 32;
  constexpr int LDA = MODE == 0 ? DM : MLD;
  f32x4 acc[8][4];
#pragma unroll
  for (int i = 0; i < 8; ++i)
#pragma unroll
    for (int j = 0; j < 4; ++j) acc[i][j] = f32x4{0.f, 0.f, 0.f, 0.f};
  float ss0 = 0.f, ss1 = 0.f, ss2 = 0.f, ss3 = 0.f;
  const char* bA = (const char*)(A + m0 * LDA);
  const char* bB = (const char*)(Bt + n0 * K);
  const unsigned vA = (unsigned)(lrow * LDA + lch * 8) * 2u;
  const unsigned vB = (unsigned)(lrow * K + lch * 8) * 2u;
#define G2_LOAD(S_, kt_)                                                 \
  {                                                                      \
    const unsigned ko_ = (unsigned)(kt_) * 64u;                          \
    S_##a0 = *(const uint4*)(bA + (vA + ko_));                           \
    S_##a1 = *(const uint4*)(bA + (size_t)64 * LDA * 2 + (vA + ko_));    \
    S_##a2 = *(const uint4*)(bA + (size_t)128 * LDA * 2 + (vA + ko_));   \
    S_##a3 = *(const uint4*)(bA + (size_t)192 * LDA * 2 + (vA + ko_));   \
    S_##b0 = *(const uint4*)(bB + (vB + ko_));                           \
    S_##b1 = *(const uint4*)(bB + (size_t)64 * K * 2 + (vB + ko_));      \
  }
#define G2_SSQ(acc_, v_)                                                                          \
  {                                                                                               \
    acc_ = __builtin_amdgcn_fdot2_f32_bf16(__builtin_bit_cast(bf16x2_t, v_.x), __builtin_bit_cast(bf16x2_t, v_.x), acc_, false); \
    acc_ = __builtin_amdgcn_fdot2_f32_bf16(__builtin_bit_cast(bf16x2_t, v_.y), __builtin_bit_cast(bf16x2_t, v_.y), acc_, false); \
    acc_ = __builtin_amdgcn_fdot2_f32_bf16(__builtin_bit_cast(bf16x2_t, v_.z), __builtin_bit_cast(bf16x2_t, v_.z), acc_, false); \
    acc_ = __builtin_amdgcn_fdot2_f32_bf16(__builtin_bit_cast(bf16x2_t, v_.w), __builtin_bit_cast(bf16x2_t, v_.w), acc_, false); \
  }
#define G2_STASH(S_, buf_)                                               \
  {                                                                      \
    u16* dA_ = sA + ((buf_) * 256 + lrow) * LDT2 + wsw * 8;              \
    u16* dB_ = sB + ((buf_) * 128 + lrow) * LDT2 + wsw * 8;              \
    *(uint4*)(dA_) = S_##a0;                                             \
    *(uint4*)(dA_ + 64 * LDT2) = S_##a1;                                 \
    *(uint4*)(dA_ + 128 * LDT2) = S_##a2;                                \
    *(uint4*)(dA_ + 192 * LDT2) = S_##a3;                                \
    *(uint4*)(dB_) = S_##b0;                                             \
    *(uint4*)(dB_ + 64 * LDT2) = S_##b1;                                 \
    if (MODE == 0) { G2_SSQ(ss0, S_##a0) G2_SSQ(ss1, S_##a1) G2_SSQ(ss2, S_##a2) G2_SSQ(ss3, S_##a3) } \
  }
#define G2_COMPUTE(cur_)                                                                                   \
  {                                                                                                        \
    bf16x8 bfr[4], af[8];                                                                                  \
    _Pragma("unroll") for (int n = 0; n < 4; ++n)                                                          \
      bfr[n] = *(const bf16x8*)(sB + ((cur_) * 128 + wc * 64 + n * 16 + fr) * LDT2 + rsw * 8);             \
    _Pragma("unroll") for (int m = 0; m < 8; ++m)                                                          \
      af[m] = *(const bf16x8*)(sA + ((cur_) * 256 + wr * 128 + m * 16 + fr) * LDT2 + rsw * 8);             \
    _Pragma("unroll") for (int m = 0; m < 8; ++m)                                                          \
      _Pragma("unroll") for (int n = 0; n < 4; ++n)                                                        \
        acc[m][n] = __builtin_amdgcn_mfma_f32_16x16x32_bf16(af[m], bfr[n], acc[m][n], 0, 0, 0);           \
                      \
    __builtin_amdgcn_sched_group_barrier(0x100, 6, 0);                                                     \
    _Pragma("unroll") for (int m = 0; m < 6; ++m) {                                                        \
      __builtin_amdgcn_sched_group_barrier(0x008, 4, 0);                                                   \
      __builtin_amdgcn_sched_group_barrier(0x100, 1, 0);                                                   \
    }                                                                                                      \
    __builtin_amdgcn_sched_group_barrier(0x008, 8, 0);                                                     \
  }
  uint4 Xa0, Xa1, Xa2, Xa3, Xb0, Xb1, Ya0, Ya1, Ya2, Ya3, Yb0, Yb1;
  __syncthreads();
  G2_LOAD(X, 0);
  G2_LOAD(Y, 1);
  G2_STASH(X, 0);
  __syncthreads();
  for (int kt = 0; kt < NK; kt += 2) {
    { const int k2 = kt + 2 < NK ? kt + 2 : NK - 1; G2_LOAD(X, k2); }
    G2_COMPUTE(0);
    G2_STASH(Y, 1);
    __syncthreads();
    { const int k3 = kt + 3 < NK ? kt + 3 : NK - 1; G2_LOAD(Y, k3); }
    G2_COMPUTE(1);
    if (kt + 2 < NK) G2_STASH(X, 0);
    __syncthreads();
  }
#undef G2_LOAD
#undef G2_STASH
#undef G2_COMPUTE
#undef G2_SSQ
  if (MODE == 0) {
    {
      float s0 = ss0, s1 = ss1, s2 = ss2, s3 = ss3;
      s0 += __shfl_xor(s0, 1); s0 += __shfl_xor(s0, 2);
      s1 += __shfl_xor(s1, 1); s1 += __shfl_xor(s1, 2);
      s2 += __shfl_xor(s2, 1); s2 += __shfl_xor(s2, 2);
      s3 += __shfl_xor(s3, 1); s3 += __shfl_xor(s3, 2);
      if (lch == 0) {
        rs[lrow] = rsqrtf(s0 * (1.f / DM) + 1e-6f);
        rs[lrow + 64] = rsqrtf(s1 * (1.f / DM) + 1e-6f);
        rs[lrow + 128] = rsqrtf(s2 * (1.f / DM) + 1e-6f);
        rs[lrow + 192] = rsqrtf(s3 * (1.f / DM) + 1e-6f);
      }
    }
    __syncthreads();
    const bool isqk = false;
    if (isqk) {
      const float* nwp = (nt >= 23 ? p.k_norm_w : p.q_norm_w) + layer * 64;
      float nwv[4];
#pragma unroll
      for (int n = 0; n < 4; ++n) nwv[n] = nwp[16 * n + fr];
#pragma unroll
      for (int m = 0; m < 8; ++m)
#pragma unroll
        for (int j = 0; j < 4; ++j) {
          const int row = wr * 128 + m * 16 + fq * 4 + j;
          const float r = rs[row];
          float v[4];
          float sq = 0.f;
#pragma unroll
          for (int n = 0; n < 4; ++n) { v[n] = acc[m][n][j] * r; sq += v[n] * v[n]; }
          sq += __shfl_xor(sq, 1); sq += __shfl_xor(sq, 2); sq += __shfl_xor(sq, 4); sq += __shfl_xor(sq, 8);
          const float rr = rsqrtf(sq * (1.f / 64.f) + 1e-6f);
#pragma unroll
          for (int n = 0; n < 4; ++n) v[n] = v[n] * rr * nwv[n];
          const float partner = __shfl_xor(v[0], 8);
          const int t = (int)((m0 + row) & (SEQ - 1));
          const float2 cssn = *(const float2*)(p.ropeT + ((size_t)t * 8 + (fr & 7)) * 2);
          v[0] = fr < 8 ? v[0] * cssn.x - partner * cssn.y : v[0] * cssn.x + partner * cssn.y;
#pragma unroll
          for (int n = 0; n < 4; ++n) p.P[(m0 + row) * NP + n0 + wc * 64 + n * 16 + fr] = f2bf(v[n]);
        }
    } else {
#pragma unroll
      for (int m = 0; m < 8; ++m)
#pragma unroll
        for (int j = 0; j < 4; ++j) {
          const int row = wr * 128 + m * 16 + fq * 4 + j;
          const float r = rs[row];
#pragma unroll
          for (int n = 0; n < 4; ++n) {
            const int col = wc * 64 + n * 16 + fr;
            const float v = acc[m][n][j] * r;
            if (nt < 32) p.P[(m0 + row) * NP + n0 + col] = f2bf(v);
            else if (col < 16) p.BA[(m0 + row) * 16 + col] = v;
          }
        }
    }
  } else {
#pragma unroll
    for (int m = 0; m < 8; ++m) {
      float rv[16];
#pragma unroll
      for (int j = 0; j < 4; ++j)
#pragma unroll
        for (int n = 0; n < 4; ++n) {
          const float* ptr_ = resid + (m0 + wr * 128 + m * 16 + fq * 4 + j) * DM + n0 + wc * 64 + n * 16 + fr;
          asm volatile("global_load_dword %0, %1, off" : "=v"(rv[j * 4 + n]) : "v"(ptr_) : "memory");
        }
      asm volatile("s_waitcnt vmcnt(0)"
                   : "+v"(rv[0]), "+v"(rv[1]), "+v"(rv[2]), "+v"(rv[3]), "+v"(rv[4]), "+v"(rv[5]), "+v"(rv[6]), "+v"(rv[7]),
                     "+v"(rv[8]), "+v"(rv[9]), "+v"(rv[10]), "+v"(rv[11]), "+v"(rv[12]), "+v"(rv[13]), "+v"(rv[14]), "+v"(rv[15])
                   :: "memory");
#pragma unroll
      for (int j = 0; j < 4; ++j)
#pragma unroll
        for (int n = 0; n < 4; ++n) {
          const size_t o = (m0 + wr * 128 + m * 16 + fq * 4 + j) * DM + n0 + wc * 64 + n * 16 + fr;
          rv[j * 4 + n] += acc[m][n][j];
          p.out[o] = rv[j * 4 + n];
        }
      if (layer == 0) {
#pragma unroll
        for (int j = 0; j < 4; ++j)
#pragma unroll
          for (int n = 0; n < 4; ++n)
            p.xb[(m0 + wr * 128 + m * 16 + fq * 4 + j) * DM + n0 + wc * 64 + n * 16 + fr] = f2bf(rv[j * 4 + n]);
      }
    }
  }
}

__device__ void phase_inproj(const Params& p, int layer, char* smem, int bid, int nblk) {
  const u16* Bt = p.WinT + (size_t)layer * NPAD * DM;
  const bool aff = (nblk & 7) == 0;
  const int x = bid & 7, slot = bid >> 3, nslot = nblk >> 3;
  const int start = aff ? slot : bid, step = aff ? nslot : nblk, total = aff ? 16 * 33 : 128 * 33;
  for (int j = start; j < total; j += step) {
    int mt, nt;
    if (aff) { const int g = j / 264, r = j % 264; mt = x * 16 + g * 8 + (r & 7); nt = r >> 3; }
    else { mt = j / 33; nt = j % 33; }
    gemm_tile<0>(p, p.xb, Bt, mt, nt, layer, nullptr, smem);
  }
}
__device__ void phase_outproj(const Params& p, int layer, char* smem, int bid, int nblk) {
  const float* resid = layer == 0 ? p.x : p.out;
  const u16* Bt = p.WoutT + (size_t)layer * DM * DM;
  const bool aff = (nblk & 7) == 0;
  const int x = bid & 7, slot = bid >> 3, nslot = nblk >> 3;
  const int start = aff ? slot : bid, step = aff ? nslot : nblk, total = aff ? 16 * 8 : 128 * 8;
  for (int j = start; j < total; j += step) {
    const int mt = aff ? x * 16 + (j >> 3) : j >> 3, nt = j & 7;
    gemm_tile<1>(p, p.mixed, Bt, mt, nt, layer, resid, smem);
  }
}

__device__ void gdn_prep(const Params& p, int layer, int ci, char* smem);
__device__ void phase_qknorm(const Params& p, int layer, char* smem, int bid, int nblk) {
  {
    const size_t nl = (size_t)NTOK * 96;
    for (size_t L = (size_t)bid * 256 + otid(); L < nl; L += (size_t)nblk * 256) {
      const int tok = (int)(L / 96), rem = (int)(L % 96), r = rem >> 3, sub = rem & 7;
      const int isk = r >= 6, t = tok & (SEQ - 1);
      u16* ptr = p.P + (size_t)tok * NP + QC + rem * 8;
      const float* nw = (isk ? p.k_norm_w : p.q_norm_w) + layer * 64 + sub * 8;
      const uint4 raw = *(const uint4*)ptr;
      float v[8];
      v[0] = __uint_as_float(raw.x << 16); v[1] = __uint_as_float(raw.x & 0xffff0000u);
      v[2] = __uint_as_float(raw.y << 16); v[3] = __uint_as_float(raw.y & 0xffff0000u);
      v[4] = __uint_as_float(raw.z << 16); v[5] = __uint_as_float(raw.z & 0xffff0000u);
      v[6] = __uint_as_float(raw.w << 16); v[7] = __uint_as_float(raw.w & 0xffff0000u);
      float ssq = 0.f;
#pragma unroll
      for (int e = 0; e < 8; ++e) ssq += v[e] * v[e];
      ssq += __shfl_xor(ssq, 1); ssq += __shfl_xor(ssq, 2); ssq += __shfl_xor(ssq, 4);
      const float rr = rsqrtf(ssq * (1.f / 64.f) + 1e-6f);
#pragma unroll
      for (int e = 0; e < 8; ++e) v[e] = v[e] * rr * nw[e];
      float pv[8];
#pragma unroll
      for (int e = 0; e < 8; ++e) pv[e] = __shfl_xor(v[e], 1);
      if (sub < 2) {
        const float4* rt = (const float4*)(p.ropeT + (size_t)t * 16);
        const float4 c0 = rt[0], c1 = rt[1], c2 = rt[2], c3 = rt[3];
        const float cs[8] = {c0.x, c0.z, c1.x, c1.z, c2.x, c2.z, c3.x, c3.z};
        const float sn[8] = {c0.y, c0.w, c1.y, c1.w, c2.y, c2.w, c3.y, c3.w};
#pragma unroll
        for (int e = 0; e < 8; ++e) v[e] = sub == 0 ? v[e] * cs[e] - pv[e] * sn[e] : v[e] * cs[e] + pv[e] * sn[e];
      }
      uint4 o;
      o.x = pk2(v[0], v[1]); o.y = pk2(v[2], v[3]); o.z = pk2(v[4], v[5]); o.w = pk2(v[6], v[7]);
      *(uint4*)ptr = o;
    }
  }
  for (int u = bid; u < 96 * 32; u += nblk) gdn_prep(p, layer, u, smem);
}

DI bf16x8 packB(const f32x4& a, const f32x4& b) {
  typedef unsigned u32x4 __attribute__((ext_vector_type(4)));
  u32x4 r;
  r[0] = pk2(a[0], a[1]); r[1] = pk2(a[2], a[3]); r[2] = pk2(b[0], b[1]); r[3] = pk2(b[2], b[3]);
  return __builtin_bit_cast(bf16x8, r);
}
DI bf16x8 ldfragP(const u16* X, int ld, int row, int ks, int fq) {
  typedef unsigned u32x4 __attribute__((ext_vector_type(4)));
  const u16* r = X + (size_t)row * ld + 32 * ks + 4 * fq;
  const uint2 lo = *(const uint2*)r, hi = *(const uint2*)(r + 16);
  u32x4 v; v[0] = lo.x; v[1] = lo.y; v[2] = hi.x; v[3] = hi.y;
  return __builtin_bit_cast(bf16x8, v);
}

__device__ void gdn_prep(const Params& p, int layer, int ci, char* smem) {
  float* Kf = (float*)smem;
  float* Vf = Kf + 64 * 65;
  float* Am = Vf + 64 * 65;
  u16* Qs = (u16*)(Am + 64 * 68);
  u16* Ks = Qs + 64 * 72;
  float* gcs = (float*)(Ks + 64 * 72);
  float* bts = gcs + 64;
  float* rsc = bts + 64;
  const int tid = otid(), lane = tid & 63, w = tid >> 6;
  const int n = ci & 31, bh = ci >> 5, b = bh / 6, h = bh % 6;
  const size_t tok0 = (size_t)b * SEQ + n * 64;
  const size_t cb = (size_t)ci * 4096;
  if (w == 0) {
    const size_t tok = tok0 + lane;
    const float beta = sigmoidf(p.BA[tok * 16 + h]);
    const float g = -expf(p.a_log[layer * 6 + h]) * softplus(p.BA[tok * 16 + 6 + h] + p.dt_bias[layer * 6 + h]);
    float c = g;
#pragma unroll
    for (int o = 1; o < 64; o <<= 1) { const float t = __shfl_up(c, o); if (lane >= o) c += t; }
    gcs[lane] = c; bts[lane] = beta; rsc[lane] = beta * expf(c);
  }
  __syncthreads();
  {
    const float* cw = p.conv_w + (size_t)layer * 4 * 1152;
    unsigned rw0[19], rw1[19], rw2[19];
#define CONV_ISSUE(dst_, sec_)                                                                        \
    _Pragma("unroll") for (int j = 0; j < 19; ++j) {                                                  \
      const int tl_ = n * 64 + w * 16 + j - 3;                                                        \
      const u16* ptr_ = p.P + ((size_t)b * SEQ + (tl_ >= 0 ? tl_ : 0)) * NP + (sec_) * 384 + h * 64 + lane; \
      asm volatile("global_load_ushort %0, %1, off" : "=v"(dst_[j]) : "v"(ptr_) : "memory");          \
    }
#define CONV_WAIT(d_)                                                                                 \
    asm volatile("s_waitcnt vmcnt(0)"                                                                 \
                 : "+v"(d_[0]), "+v"(d_[1]), "+v"(d_[2]), "+v"(d_[3]), "+v"(d_[4]), "+v"(d_[5]), "+v"(d_[6]),      \
                   "+v"(d_[7]), "+v"(d_[8]), "+v"(d_[9]), "+v"(d_[10]), "+v"(d_[11]), "+v"(d_[12]), "+v"(d_[13]),  \
                   "+v"(d_[14]), "+v"(d_[15]), "+v"(d_[16]), "+v"(d_[17]), "+v"(d_[18]) :: "memory");
    CONV_ISSUE(rw0, 0)
    CONV_ISSUE(rw1, 1)
    CONV_ISSUE(rw2, 2)
    CONV_WAIT(rw0)
    CONV_WAIT(rw1)
    CONV_WAIT(rw2)
#undef CONV_ISSUE
#undef CONV_WAIT
#pragma unroll
    for (int sec = 0; sec < 3; ++sec) {
      const int col = sec * 384 + h * 64 + lane;
      float wt[4];
#pragma unroll
      for (int j = 0; j < 4; ++j) wt[j] = cw[j * 1152 + col];
      float xr[19];
#pragma unroll
      for (int j = 0; j < 19; ++j) {
        const int tl = n * 64 + w * 16 + j - 3;
        const unsigned rv = sec == 0 ? rw0[j] : (sec == 1 ? rw1[j] : rw2[j]);
        xr[j] = tl >= 0 ? __uint_as_float(rv << 16) : 0.f;
      }
      float* dst = sec == 0 ? Am : (sec == 1 ? Kf : Vf);
      const int dld = sec == 0 ? 68 : 65;
#pragma unroll
      for (int i = 0; i < 16; ++i) {
        float v = wt[0] * xr[i] + wt[1] * xr[i + 1] + wt[2] * xr[i + 2] + wt[3] * xr[i + 3];
        dst[(w * 16 + i) * dld + lane] = silu(v);
      }
    }
  }
  __syncthreads();
  {
    const int ti = tid >> 2, qd = tid & 3;
    float qv[16], kv[16];
    float sq = 0.f, sk = 0.f;
#pragma unroll
    for (int e = 0; e < 16; ++e) {
      qv[e] = Am[ti * 68 + qd * 16 + e]; kv[e] = Kf[ti * 65 + qd * 16 + e];
      sq += qv[e] * qv[e]; sk += kv[e] * kv[e];
    }
    sq += __shfl_xor(sq, 1); sq += __shfl_xor(sq, 2);
    sk += __shfl_xor(sk, 1); sk += __shfl_xor(sk, 2);
    const float rq = rsqrtf(sq + 1e-6f) * 0.125f, rk = rsqrtf(sk + 1e-6f);
    const float eg = fexp(gcs[ti]);
    unsigned qg[8];
#pragma unroll
    for (int e = 0; e < 16; e += 2) {
      const float q0 = qv[e] * rq, q1 = qv[e + 1] * rq, k0 = kv[e] * rk, k1 = kv[e + 1] * rk;
      *(unsigned*)(Qs + ti * 72 + qd * 16 + e) = pk2(q0, q1);
      *(unsigned*)(Ks + ti * 72 + qd * 16 + e) = pk2(k0, k1);
      Kf[ti * 65 + qd * 16 + e] = k0; Kf[ti * 65 + qd * 16 + e + 1] = k1;
      qg[e >> 1] = pk2(q0 * eg, q1 * eg);
    }
    uint4* gq = (uint4*)(p.gQG + cb + ti * 64 + qd * 16);
    gq[0] = make_uint4(qg[0], qg[1], qg[2], qg[3]);
    gq[1] = make_uint4(qg[4], qg[5], qg[6], qg[7]);
  }
  __syncthreads();
  {
    const int fr = lane & 15, fq = lane >> 4;
    bf16x8 ak[2], aq[2];
#pragma unroll
    for (int ks = 0; ks < 2; ++ks) {
      ak[ks] = *(const bf16x8*)(Ks + (16 * w + fr) * 72 + ks * 32 + fq * 8);
      aq[ks] = *(const bf16x8*)(Qs + (16 * w + fr) * 72 + ks * 32 + fq * 8);
    }
#pragma unroll
    for (int nn = 0; nn < 4; ++nn) {
      f32x4 cA = {0.f, 0.f, 0.f, 0.f}, cQ = {0.f, 0.f, 0.f, 0.f};
#pragma unroll
      for (int ks = 0; ks < 2; ++ks) {
        const bf16x8 bk = *(const bf16x8*)(Ks + (16 * nn + fr) * 72 + ks * 32 + fq * 8);
        cA = __builtin_amdgcn_mfma_f32_16x16x32_bf16(ak[ks], bk, cA, 0, 0, 0);
        cQ = __builtin_amdgcn_mfma_f32_16x16x32_bf16(aq[ks], bk, cQ, 0, 0, 0);
      }
#pragma unroll
      for (int j = 0; j < 4; ++j) {
        const int i = 16 * w + 4 * fq + j, jj = 16 * nn + fr;
        const float dec = (i >= jj) ? fexp(gcs[i] - gcs[jj]) : 0.f;
        Am[i * 68 + jj] = (i > jj) ? bts[i] * cA[j] * dec : 0.f;
        p.gQK[cb + i * 64 + jj] = f2bf(cQ[j] * dec);
      }
    }
  }
  __syncthreads();
  if (tid < 128) {
    const int c = tid & 63;
    const bool isw = tid >= 64;
    const float* X = isw ? Kf : Vf;
    const float* sc = isw ? rsc : bts;
    float x[64];
#pragma unroll
    for (int i = 0; i < 64; ++i) {
      float acc = sc[i] * X[i * 65 + c];
#pragma unroll
      for (int j = 0; j < i; ++j) acc -= Am[i * 68 + j] * x[j];
      x[i] = acc;
      if (isw) p.gW[cb + i * 64 + c] = f2bf(-acc);
      else p.gU[cb + i * 64 + c] = acc;
      asm volatile("" ::: "memory");
    }
  } else {
    const float e = fexp(gcs[63] - gcs[lane]);
    for (int d = 0; d < 32; ++d) {
      const int dk = (w - 2) * 32 + d;
      p.gKGt[cb + dk * 64 + lane] = f2bf(Kf[lane * 65 + dk] * e);
    }
    if (tid == 128) p.gGL[ci] = expf(gcs[63]);
  }
  __syncthreads();
}

__device__ void gdn_rec(const Params& p, int layer, int bh, char* smem) {
  u16* sM = (u16*)smem;
  u16* sZ = sM + 4 * 64 * 72;
  float* part = (float*)(sZ + 64 * 72);
  const int tid = otid(), lane = tid & 63, w = tid >> 6, fr = lane & 15, fq = lane >> 4;
  const int b = bh / 6, h = bh % 6;
  f32x4 S[4];
#pragma unroll
  for (int m = 0; m < 4; ++m) S[m] = f32x4{0.f, 0.f, 0.f, 0.f};
  const float gw = p.gdn_norm_w[layer * 64 + 16 * w + fr];
  const int srow = tid >> 3, sch = tid & 7;
  uint4 A0, A1, A2, A3, A4, A5, A6, A7, A8, A9, B0, B1, B2, B3, B4, B5, B6, B7, B8, B9;
  f32x4 Au[4], Bu[4], uc[4];
  float Agl, Bgl, glc;
#define GDN_LOAD(S_, nn_)                                                                     \
  {                                                                                           \
    const size_t cb_ = ((size_t)bh * 32 + (nn_)) * 4096;                                      \
    const size_t o0_ = cb_ + srow * 64 + sch * 8, o1_ = o0_ + 32 * 64;                        \
    S_##0 = *(const uint4*)(p.gW + o0_);   S_##1 = *(const uint4*)(p.gW + o1_);               \
    S_##2 = *(const uint4*)(p.gQG + o0_);  S_##3 = *(const uint4*)(p.gQG + o1_);              \
    S_##4 = *(const uint4*)(p.gQK + o0_);  S_##5 = *(const uint4*)(p.gQK + o1_);              \
    S_##6 = *(const uint4*)(p.gKGt + o0_); S_##7 = *(const uint4*)(p.gKGt + o1_);             \
    const u16* zp_ = p.P + ((size_t)b * SEQ + (nn_) * 64 + srow) * NP + ZA + h * 64 + sch * 8; \
    S_##8 = *(const uint4*)(zp_);          S_##9 = *(const uint4*)(zp_ + (size_t)32 * NP);    \
    _Pragma("unroll") for (int m = 0; m < 4; ++m)                                             \
      _Pragma("unroll") for (int j = 0; j < 4; ++j)                                           \
        S_##u[m][j] = p.gU[cb_ + (16 * m + 4 * fq + j) * 64 + 16 * w + fr];                   \
    S_##gl = p.gGL[bh * 32 + (nn_)];                                                          \
  }
#define GDN_STASH(S_)                                                                         \
  {                                                                                           \
    u16* d0_ = sM + srow * 72 + sch * 8;                                                      \
    u16* d1_ = d0_ + 32 * 72;                                                                 \
    *(uint4*)(d0_) = S_##0;               *(uint4*)(d1_) = S_##1;                             \
    *(uint4*)(d0_ + 64 * 72) = S_##2;     *(uint4*)(d1_ + 64 * 72) = S_##3;                   \
    *(uint4*)(d0_ + 2 * 64 * 72) = S_##4; *(uint4*)(d1_ + 2 * 64 * 72) = S_##5;               \
    *(uint4*)(d0_ + 3 * 64 * 72) = S_##6; *(uint4*)(d1_ + 3 * 64 * 72) = S_##7;               \
    *(uint4*)(d0_ + 4 * 64 * 72) = S_##8; *(uint4*)(d1_ + 4 * 64 * 72) = S_##9;               \
    _Pragma("unroll") for (int m = 0; m < 4; ++m) uc[m] = S_##u[m];                           \
    glc = S_##gl;                                                                             \
  }
#define GDN_BODY(n_, NEXT_)                                                                   \
  {                                                                                           \
    bf16x8 Sb[2], Vb[2];                                                                      \
    Sb[0] = packB(S[0], S[1]);                                                                \
    Sb[1] = packB(S[2], S[3]);                                                                \
    f32x4 av[4];                                                                              \
    _Pragma("unroll") for (int m = 0; m < 4; ++m) {                                           \
      av[m] = uc[m];                                                                          \
      _Pragma("unroll") for (int ks = 0; ks < 2; ++ks)                                        \
        av[m] = __builtin_amdgcn_mfma_f32_16x16x32_bf16(ldfragP(sM, 72, 16 * m + fr, ks, fq), Sb[ks], av[m], 0, 0, 0); \
    }                                                                                         \
    Vb[0] = packB(av[0], av[1]);                                                              \
    Vb[1] = packB(av[2], av[3]);                                                              \
    f32x4 O[4];                                                                               \
    _Pragma("unroll") for (int m = 0; m < 4; ++m) {                                           \
      f32x4 o = {0.f, 0.f, 0.f, 0.f};                                                         \
      _Pragma("unroll") for (int ks = 0; ks < 2; ++ks) {                                      \
        o = __builtin_amdgcn_mfma_f32_16x16x32_bf16(ldfragP(sM + 64 * 72, 72, 16 * m + fr, ks, fq), Sb[ks], o, 0, 0, 0);     \
        o = __builtin_amdgcn_mfma_f32_16x16x32_bf16(ldfragP(sM + 2 * 64 * 72, 72, 16 * m + fr, ks, fq), Vb[ks], o, 0, 0, 0); \
      }                                                                                       \
      O[m] = o;                                                                               \
    }                                                                                         \
    _Pragma("unroll") for (int m = 0; m < 4; ++m) {                                           \
      f32x4 sacc = S[m] * glc;                                                                \
      _Pragma("unroll") for (int ks = 0; ks < 2; ++ks)                                        \
        sacc = __builtin_amdgcn_mfma_f32_16x16x32_bf16(ldfragP(sM + 3 * 64 * 72, 72, 16 * m + fr, ks, fq), Vb[ks], sacc, 0, 0, 0); \
      S[m] = sacc;                                                                            \
    }                                                                                         \
    f32x4 zc[4];                                                                              \
    _Pragma("unroll") for (int m = 0; m < 4; ++m)                                             \
      _Pragma("unroll") for (int j = 0; j < 4; ++j)                                           \
        zc[m][j] = bf2f(sZ[(16 * m + 4 * fq + j) * 72 + 16 * w + fr]);                        \
    _Pragma("unroll") for (int hh = 0; hh < 2; ++hh) {                                        \
      f32x4 sq0 = O[2 * hh] * O[2 * hh], sq1 = O[2 * hh + 1] * O[2 * hh + 1];                 \
      _Pragma("unroll") for (int msk = 1; msk < 16; msk <<= 1) {                              \
        _Pragma("unroll") for (int j = 0; j < 4; ++j) {                                       \
          sq0[j] += __shfl_xor(sq0[j], msk); sq1[j] += __shfl_xor(sq1[j], msk);               \
        }                                                                                     \
      }                                                                                       \
      if (fr == 0) {                                                                          \
        *(f32x4*)(part + w * 64 + 16 * (2 * hh) + 4 * fq) = sq0;                              \
        *(f32x4*)(part + w * 64 + 16 * (2 * hh + 1) + 4 * fq) = sq1;                          \
      }                                                                                       \
    }                                                                                         \
    __syncthreads();                                                                          \
    GDN_STASH(NEXT_);                                                                         \
    _Pragma("unroll") for (int m = 0; m < 4; ++m)                                             \
      _Pragma("unroll") for (int j = 0; j < 4; ++j) {                                         \
        const int row = 16 * m + 4 * fq + j;                                                  \
        const float tot = (part[row] + part[64 + row]) + (part[128 + row] + part[192 + row]); \
        const float rr = rsqrtf(tot * (1.f / 64.f) + 1e-6f);                                  \
        const size_t tok = (size_t)b * SEQ + (n_) * 64 + row;                                 \
        const int col = h * 64 + 16 * w + fr;                                                 \
        p.mixed[tok * MLD + col] = f2bf(O[m][j] * rr * gw * silu(zc[m][j]));                  \
      }                                                                                       \
    __syncthreads();                                                                          \
  }
  __syncthreads();
  __builtin_amdgcn_s_setprio(3);
  GDN_LOAD(A, 0);
  GDN_LOAD(B, 1);
  GDN_STASH(A);
  __syncthreads();
  for (int n = 0; n < 32; n += 2) {
    { const int n2 = n + 2 < 32 ? n + 2 : 31; GDN_LOAD(A, n2); }
    GDN_BODY(n, B);
    { const int n3 = n + 3 < 32 ? n + 3 : 31; GDN_LOAD(B, n3); }
    GDN_BODY(n + 1, A);
  }
  __builtin_amdgcn_s_setprio(0);
#undef GDN_LOAD
#undef GDN_STASH
#undef GDN_BODY
}

typedef short s16x4 __attribute__((ext_vector_type(4)));
DI s16x4 tr_read(const u16* lds_ptr) {
  return __builtin_amdgcn_ds_read_tr16_b64_v4i16((__attribute__((address_space(3))) s16x4*)(lds_ptr));
}
DI bf16x8 vt_frag(const u16* sV, int key0, int mm, int lane) {
  const int fq = lane >> 4, q = (lane & 15) >> 2, pp = lane & 3;
  const u16* a = sV + (key0 + 4 * fq + q) * 72 + 16 * mm + 4 * pp;
  const s16x4 lo = tr_read(a), hi = tr_read(a + 16 * 72);
  return __builtin_shufflevector(lo, hi, 0, 1, 2, 3, 4, 5, 6, 7);
}

__device__ void sb_mfma(const Params& p, int unit, char* smem) {
  u16* sK = (u16*)smem;
  u16* sV = sK + 2 * 64 * 72;
  const int tid = otid(), lane = tid & 63, w = tid >> 6, fr = lane & 15, fq = lane >> 4;
  const int bh = unit & 63, qb = 31 - (unit >> 6), b = bh >> 2, h = bh & 3;
  const int t0 = qb * 64;
  const int tq = t0 + 16 * w + fr;
  const size_t tokq = (size_t)b * SEQ + tq;
  bf16x8 qf[2];
#pragma unroll
  for (int ks = 0; ks < 2; ++ks) qf[ks] = *(const bf16x8*)(p.P + tokq * NP + QB + h * 64 + 32 * ks + 8 * fq);
  f32x4 ot[4];
#pragma unroll
  for (int mm = 0; mm < 4; ++mm) ot[mm] = f32x4{0.f, 0.f, 0.f, 0.f};
  const u16* zp_ = p.P + tokq * NP + ZB + h * 64 + 4 * fq;
  const uint2 zq0 = *(const uint2*)(zp_), zq1 = *(const uint2*)(zp_ + 16), zq2 = *(const uint2*)(zp_ + 32), zq3 = *(const uint2*)(zp_ + 48);
  __builtin_amdgcn_sched_barrier(0);
  float R = 0.f;
  const float csc = 0.125f * 1.44269504088896f;
  const int lrow = tid >> 3, lch = tid & 7;
  const u16* gk = p.P + ((size_t)b * SEQ + lrow) * NP + KB + h * 64 + lch * 8;
  const u16* gv = p.P + ((size_t)b * SEQ + lrow) * NP + VB + h * 64 + lch * 8;
  uint4 rk0, rk1, rv0, rv1;
  __syncthreads();
  rk0 = *(const uint4*)(gk + (size_t)(qb * 64) * NP);
  rk1 = *(const uint4*)(gk + (size_t)(qb * 64 + 32) * NP);
  rv0 = *(const uint4*)(gv + (size_t)(qb * 64) * NP);
  rv1 = *(const uint4*)(gv + (size_t)(qb * 64 + 32) * NP);
  const int kws = (lch ^ (((lrow >> 1) & 3) << 1)) * 8;
  const int krs = ((fr >> 1) & 3) << 1;
  *(uint4*)(sK + lrow * 64 + kws) = rk0;
  *(uint4*)(sK + (lrow + 32) * 64 + kws) = rk1;
  *(uint4*)(sV + lrow * 72 + lch * 8) = rv0;
  *(uint4*)(sV + (lrow + 32) * 72 + lch * 8) = rv1;
  __syncthreads();
  int cur = 0;
  for (int kt = qb; kt >= 0; --kt) {
    {
      const int kn = kt > 0 ? kt - 1 : 0;
      rk0 = *(const uint4*)(gk + (size_t)(kn * 64) * NP);
      rk1 = *(const uint4*)(gk + (size_t)(kn * 64 + 32) * NP);
      rv0 = *(const uint4*)(gv + (size_t)(kn * 64) * NP);
      rv1 = *(const uint4*)(gv + (size_t)(kn * 64 + 32) * NP);
    }
    __builtin_amdgcn_sched_barrier(0);
    const u16* cK = sK + cur * 64 * 72;
    const u16* cV = sV + cur * 64 * 72;
    f32x4 st[4];
#pragma unroll
    for (int m = 0; m < 4; ++m) {
      st[m] = f32x4{0.f, 0.f, 0.f, 0.f};
#pragma unroll
      for (int ks = 0; ks < 2; ++ks)
        st[m] = __builtin_amdgcn_mfma_f32_16x16x32_bf16(*(const bf16x8*)(cK + (16 * m + fr) * 64 + (((4 * ks + fq) ^ krs) * 8)), qf[ks], st[m], 0, 0, 0);
    }
    float lk[4][4], lb[4][4], G[4], T[4], E[4];
#pragma unroll
    for (int m = 0; m < 4; ++m) {
#pragma unroll
      for (int j = 0; j < 4; ++j) {
        const float z2 = st[m][j] * csc;
        const float sp = fmaxf(z2, 0.f) + lg2(1.f + ex2(-fabsf(z2)));
        const bool valid = kt != qb || (kt * 64 + 16 * m + 4 * fq + j) < tq;
        lk[m][j] = valid ? -sp : 0.f;
        lb[m][j] = valid ? z2 - sp : -1e30f;
      }
      G[m] = (lk[m][0] + lk[m][1]) + (lk[m][2] + lk[m][3]);
    }
#pragma unroll
    for (int m = 0; m < 4; ++m) {
      const float a = __shfl_xor(G[m], 16);
      const float s1 = G[m] + a;
      const float c2 = __shfl_xor(s1, 32);
      T[m] = s1 + c2;
      E[m] = fq == 0 ? (a + c2) : (fq == 1 ? c2 : (fq == 2 ? a : 0.f));
    }
    float base = R;
    f32x4 wt[4];
#pragma unroll
    for (int m = 3; m >= 0; --m) {
      float e = base + E[m];
#pragma unroll
      for (int j = 3; j >= 0; --j) {
        wt[m][j] = ex2(lb[m][j] + e);
        e += lk[m][j];
      }
      base += T[m];
    }
    R = base;
    bf16x8 pb[2];
    pb[0] = packB(wt[0], wt[1]);
    pb[1] = packB(wt[2], wt[3]);
#pragma unroll
    for (int mm = 0; mm < 4; ++mm)
#pragma unroll
      for (int k2 = 0; k2 < 2; ++k2)
        ot[mm] = __builtin_amdgcn_mfma_f32_16x16x32_bf16(vt_frag(cV, 32 * k2, mm, lane), pb[k2], ot[mm], 0, 0, 0);
    {
      u16* nK = sK + (cur ^ 1) * 64 * 72;
      u16* nV = sV + (cur ^ 1) * 64 * 72;
      *(uint4*)(nK + lrow * 64 + kws) = rk0;
      *(uint4*)(nK + (lrow + 32) * 64 + kws) = rk1;
      *(uint4*)(nV + lrow * 72 + lch * 8) = rv0;
      *(uint4*)(nV + (lrow + 32) * 72 + lch * 8) = rv1;
    }
    __syncthreads();
    cur ^= 1;
  }
#pragma unroll
  for (int mm = 0; mm < 4; ++mm) {
    const int dh = 16 * mm + 4 * fq;
    const uint2 zr = mm == 0 ? zq0 : (mm == 1 ? zq1 : (mm == 2 ? zq2 : zq3));
    const unsigned zx = zr.x, zy = zr.y;
    const float z0 = __uint_as_float(zx << 16), z1 = __uint_as_float(zx & 0xffff0000u);
    const float z2 = __uint_as_float(zy << 16), z3 = __uint_as_float(zy & 0xffff0000u);
    uint2 o;
    o.x = pk2(ot[mm][0] * silu(z0), ot[mm][1] * silu(z1));
    o.y = pk2(ot[mm][2] * silu(z2), ot[mm][3] * silu(z3));
    *(uint2*)(p.mixed + tokq * MLD + 384 + h * 64 + dh) = o;
  }
}

__device__ void dil_mfma(const Params& p, int unit, char* smem) {
  const int tid = otid(), lane = tid & 63, w = tid >> 6, fr = lane & 15, fq = lane >> 4;
  u16* sV = (u16*)smem + w * (32 * 72);
  const int rq = unit & 3, a = (unit >> 2) & 7, bh = unit >> 5, b = bh / 6, h = bh % 6;
  const int r = 4 * rq + w;
  const int tq = r + 16 * (16 * a + fr);
  const size_t tokq = (size_t)b * SEQ + tq;
  bf16x8 qf[2];
#pragma unroll
  for (int ks = 0; ks < 2; ++ks) qf[ks] = *(const bf16x8*)(p.P + tokq * NP + QC + h * 64 + 32 * ks + 8 * fq);
  f32x4 ot[4];
#pragma unroll
  for (int mm = 0; mm < 4; ++mm) ot[mm] = f32x4{0.f, 0.f, 0.f, 0.f};
  float Ls = 0.f;
  const u16* zp_ = p.P + tokq * NP + ZC + h * 64 + 4 * fq;
  const uint2 zq0 = *(const uint2*)(zp_), zq1 = *(const uint2*)(zp_ + 16), zq2 = *(const uint2*)(zp_ + 32), zq3 = *(const uint2*)(zp_ + 48);
  __builtin_amdgcn_sched_barrier(0);
  const float csc = 0.125f * 1.44269504088896f;
  const u16* kbase = p.P + (size_t)b * SEQ * NP + KC + h * 64;
  const u16* vbase = p.P + (size_t)b * SEQ * NP + VC + h * 64;
  int g = 0, stp = 0;
  int d = 1, rr = 0, lo = r + 256 * a - 128, nsteps = 12, iq = r + 256 * a + 16 * fr, imax = SEQ - 1;
  bf16x8 k00, k01, k10, k11;
  uint4 v0, v1, v2, v3;
#define DIL_LOAD(d_, rr_, i0_, imax_)                                                            \
  {                                                                                              \
    const int ib_ = (i0_) + (lane >> 3);                                                         \
    const u16* vb_ = vbase + (lane & 7) * 8;                                                     \
    v0 = *(const uint4*)(vb_ + (size_t)((rr_) + (d_) * min(max(ib_, 0), (imax_))) * NP);         \
    v1 = *(const uint4*)(vb_ + (size_t)((rr_) + (d_) * min(max(ib_ + 8, 0), (imax_))) * NP);     \
    v2 = *(const uint4*)(vb_ + (size_t)((rr_) + (d_) * min(max(ib_ + 16, 0), (imax_))) * NP);    \
    v3 = *(const uint4*)(vb_ + (size_t)((rr_) + (d_) * min(max(ib_ + 24, 0), (imax_))) * NP);    \
    const u16* ka_ = kbase + (size_t)((rr_) + (d_) * min(max((i0_) + fr, 0), (imax_))) * NP + 8 * fq;       \
    const u16* kb_ = kbase + (size_t)((rr_) + (d_) * min(max((i0_) + 16 + fr, 0), (imax_))) * NP + 8 * fq;  \
    k00 = *(const bf16x8*)(ka_); k01 = *(const bf16x8*)(ka_ + 32);                               \
    k10 = *(const bf16x8*)(kb_); k11 = *(const bf16x8*)(kb_ + 32);                               \
  }
  DIL_LOAD(d, rr, lo, imax);
  while (g < 3) {
    const bf16x8 c00 = k00, c01 = k01, c10 = k10, c11 = k11;
    const uint4 w0 = v0, w1 = v1, w2 = v2, w3 = v3;
    const int i0 = lo + 32 * stp, iqc = iq;
    int ng = g, nstp = stp + 1;
    if (nstp >= nsteps) { ng = g + 1; nstp = 0; }
    if (ng != g) {
      if (ng == 1) { d = 4; rr = r & 3; lo = (r >> 2) + 64 * a - 128; nsteps = 6; iq = (r >> 2) + 64 * a + 4 * fr; imax = SEQ / 4 - 1; }
      else { d = 16; rr = r; lo = 0; nsteps = (a + 2) >> 1; iq = 16 * a + fr; imax = SEQ / 16 - 1; }
    }
    g = ng; stp = nstp;
    DIL_LOAD(d, rr, lo + 32 * stp, imax);
    __builtin_amdgcn_sched_barrier(0);
    f32x4 st0 = {0.f, 0.f, 0.f, 0.f}, st1 = {0.f, 0.f, 0.f, 0.f};
    st0 = __builtin_amdgcn_mfma_f32_16x16x32_bf16(c00, qf[0], st0, 0, 0, 0);
    st0 = __builtin_amdgcn_mfma_f32_16x16x32_bf16(c01, qf[1], st0, 0, 0, 0);
    st1 = __builtin_amdgcn_mfma_f32_16x16x32_bf16(c10, qf[0], st1, 0, 0, 0);
    st1 = __builtin_amdgcn_mfma_f32_16x16x32_bf16(c11, qf[1], st1, 0, 0, 0);
    {
      u16* dv = sV + (lane >> 3) * 72 + (lane & 7) * 8;
      *(uint4*)(dv) = w0; *(uint4*)(dv + 8 * 72) = w1; *(uint4*)(dv + 16 * 72) = w2; *(uint4*)(dv + 24 * 72) = w3;
    }
    f32x4 wt0, wt1;
    const int vlo = iqc - 128 > 0 ? iqc - 128 : 0;
    const unsigned vspan = (unsigned)(iqc - vlo);
    const int vb = i0 + 4 * fq - vlo;
#pragma unroll
    for (int j = 0; j < 4; ++j) {
      const unsigned d0 = (unsigned)(vb + j), d1 = d0 + 16u;
      const float e0 = d0 <= vspan ? ex2(st0[j] * csc) : 0.f;
      const float e1 = d1 <= vspan ? ex2(st1[j] * csc) : 0.f;
      wt0[j] = e0; wt1[j] = e1;
      Ls += e0 + e1;
    }
    const bf16x8 pb = packB(wt0, wt1);
#pragma unroll
    for (int mm = 0; mm < 4; ++mm)
      ot[mm] = __builtin_amdgcn_mfma_f32_16x16x32_bf16(vt_frag(sV, 0, mm, lane), pb, ot[mm], 0, 0, 0);
  }
#undef DIL_LOAD
  Ls += __shfl_xor(Ls, 16);
  Ls += __shfl_xor(Ls, 32);
  const float il = 1.f / Ls;
#pragma unroll
  for (int mm = 0; mm < 4; ++mm) {
    const int dh = 16 * mm + 4 * fq;
    const uint2 zr = mm == 0 ? zq0 : (mm == 1 ? zq1 : (mm == 2 ? zq2 : zq3));
    const unsigned zx = zr.x, zy = zr.y;
    const float z0 = __uint_as_float(zx << 16), z1 = __uint_as_float(zx & 0xffff0000u);
    const float z2 = __uint_as_float(zy << 16), z3 = __uint_as_float(zy & 0xffff0000u);
    uint2 o;
    o.x = pk2(ot[mm][0] * il * silu(z0), ot[mm][1] * il * silu(z1));
    o.y = pk2(ot[mm][2] * il * silu(z2), ot[mm][3] * il * silu(z3));
    *(uint2*)(p.mixed + tokq * MLD + 640 + h * 64 + dh) = o;
  }
}

__device__ void phase_mix(const Params& p, int layer, char* smem, int bid, int nblk) {
  const int nG = 96, nS = 64 * 32, nD = 96 * 32;
  __shared__ int s_unit;
  for (;;) {
    __syncthreads();
    if (otid() == 0) s_unit = atomicAdd(p.ctr + layer, 1);
    __syncthreads();
    const int u = s_unit;
    if (u >= nG + nS + nD) break;
    if (u < nG) gdn_rec(p, layer, u, smem);
    else if (u < nG + nS) sb_mfma(p, u - nG, smem);
    else dil_mfma(p, u - nG - nS, smem);
  }
}


#define XB_TMO      128
#define XB_XCNT(j)  (256  + 64 * (j))
#define XB_XSUB(j)  (1280 + 64 * (j))
#define XB_XGEN(j)  (2304 + 64 * (j))
#define XB_TOP      3328
#define XB_TOPGEN   3392
#define XCD_BAR_WORDS 3456
#define XB_SPIN_CAP (1u << 20)
#define LAS __attribute__((address_space(3)))
DI unsigned xb_ld(unsigned* p) { return __hip_atomic_load(p, __ATOMIC_RELAXED, __HIP_MEMORY_SCOPE_AGENT); }
DI unsigned xb_add(unsigned* p, unsigned v) { return __hip_atomic_fetch_add(p, v, __ATOMIC_RELAXED, __HIP_MEMORY_SCOPE_AGENT); }
DI unsigned xb_xcc_id() { return (unsigned)__builtin_amdgcn_s_getreg((3 << 11) | 20) & 0xFu; }
#define XB_SPIN(cond, bar) do { unsigned _sp = 0; while (cond) { __builtin_amdgcn_s_sleep(1); \
    if ((++_sp & 255u) == 0u) { if (xb_ld(&(bar)[XB_TMO])) break; if (_sp > XB_SPIN_CAP) { atomicAdd(&(bar)[XB_TMO], 1u); break; } } } } while (0)
struct XcdBarrier { unsigned* bar; unsigned x; volatile LAS unsigned* st; };
DI XcdBarrier xcd_barrier_post(unsigned* bar, volatile LAS unsigned* st) {
  XcdBarrier b; b.bar = bar; b.x = xb_xcc_id(); b.st = st;
  if (threadIdx.x == 0) (void)xb_add(&bar[XB_XCNT(b.x)], 1u);
  return b;
}
DI void xcd_barrier_complete(unsigned* bar, unsigned x, unsigned& nloc, unsigned& nx) {
  const unsigned G = gridDim.x * gridDim.y * gridDim.z;
  unsigned sum, cnt, mine, sp = 0u;
  for (;;) {
    sum = 0u; cnt = 0u; mine = 0u;
#pragma unroll
    for (unsigned j = 0; j < 16; ++j) { const unsigned c = xb_ld(&bar[XB_XCNT(j)]); sum += c; cnt += (c > 0u) ? 1u : 0u; mine = (j == x) ? c : mine; }
    if (sum == G) break;
    __builtin_amdgcn_s_sleep(1);
    if ((++sp & 255u) == 0u) { if (xb_ld(&bar[XB_TMO])) break; if (sp > XB_SPIN_CAP) { atomicAdd(&bar[XB_TMO], 1u); break; } }
  }
  nloc = mine > 0u ? mine : 1u; nx = cnt > 0u ? cnt : 1u;
}
DI void xcd_barrier(const XcdBarrier& b) {
  asm volatile("s_waitcnt vmcnt(0)" ::: "memory");
  __syncthreads();
  if (threadIdx.x == 0) {
    unsigned* bar = b.bar;
    __builtin_amdgcn_s_waitcnt(0);
    unsigned nloc = b.st[0], nx = b.st[1];
    if (nloc == 0u) { xcd_barrier_complete(bar, b.x, nloc, nx); b.st[0] = nloc; b.st[1] = nx; }
    const unsigned old = xb_add(&bar[XB_XSUB(b.x)], 1u);
    const unsigned gen = old / nloc;
    if (old + 1u == (gen + 1u) * nloc) {
      __builtin_amdgcn_fence(__ATOMIC_RELEASE, "agent");
      asm volatile("s_waitcnt vmcnt(0)" ::: "memory");
      const unsigned og = xb_add(&bar[XB_TOP], 1u);
      const unsigned tg = og / nx;
      if (og + 1u == (tg + 1u) * nx) xb_add(&bar[XB_TOPGEN], 1u);
      else XB_SPIN(xb_ld(&bar[XB_TOPGEN]) == tg, bar);
      __builtin_amdgcn_fence(__ATOMIC_ACQUIRE, "agent");
      xb_add(&bar[XB_XGEN(b.x)], 1u);
      asm volatile("s_waitcnt vmcnt(0)" ::: "memory");
    } else {
      XB_SPIN(xb_ld(&bar[XB_XGEN(b.x)]) == gen, bar);
      __builtin_amdgcn_fence(__ATOMIC_ACQUIRE, "agent");
      asm volatile("s_waitcnt vmcnt(0)" ::: "memory");
    }
  }
  __syncthreads();
}

constexpr int SMEM_BYTES = 70144;

__global__ void __launch_bounds__(256, 2) mega(Params p, int ph_lo, int ph_hi) {
  __shared__ __attribute__((aligned(16))) char smem[SMEM_BYTES];
  const int bid = blockIdx.x, nblk = gridDim.x;
  __shared__ uint4 xb_words;
  if (threadIdx.x == 0) xb_words = make_uint4(0u, 0u, 0u, 0u);
  __syncthreads();
  const XcdBarrier xb = xcd_barrier_post(p.bar, (volatile LAS unsigned*)&xb_words);
  if (ph_hi < 0) cg::this_grid().sync();
  for (int ph = ph_lo; ph < ph_hi; ++ph) {
    if (ph > ph_lo) {
      xcd_barrier(xb);
    }
    if (ph == 0) { phase_prep(p, (float*)smem, bid, nblk); continue; }
    const int layer = (ph - 1) / 4, sub = (ph - 1) % 4;
    if (sub == 0) { for (int r = 0; r < REP_IN; ++r) phase_inproj(p, layer, smem, bid, nblk); }
    else if (sub == 1) phase_qknorm(p, layer, smem, bid, nblk);
    else if (sub == 2) { for (int r = 0; r < REP_MIX; ++r) phase_mix(p, layer, smem, bid, nblk); }
    else phase_outproj(p, layer, smem, bid, nblk);
  }
}

extern "C" void kernel_launch(void* const* d_in, const int* in_sizes, int n_in, void* d_out, int out_size,
                              void* d_ws, size_t ws_size, hipStream_t stream) {
  Params p{};
  p.x = (const float*)d_in[0]; p.norm_w = (const float*)d_in[1]; p.w_in = (const float*)d_in[2];
  p.conv_w = (const float*)d_in[3]; p.a_log = (const float*)d_in[4]; p.dt_bias = (const float*)d_in[5];
  p.gdn_norm_w = (const float*)d_in[6]; p.q_norm_w = (const float*)d_in[7]; p.k_norm_w = (const float*)d_in[8];
  p.w_out = (const float*)d_in[9];
  p.out = (float*)d_out;
  char* ws = (char*)d_ws;
  size_t off = 0;
  auto take = [&](size_t bytes) { char* r = ws + off; off += (bytes + 255) & ~(size_t)255; return r; };
  p.WinT = (u16*)take((size_t)2 * NPAD * DM * 2);
  p.WoutT = (u16*)take((size_t)2 * DM * DM * 2);
  p.P = (u16*)take((size_t)NTOK * NP * 2);
  p.BA = (float*)take((size_t)NTOK * 16 * 4);
  p.mixed = p.P;
  p.xb = (u16*)take((size_t)NTOK * DM * 2);
  const size_t nch = (size_t)96 * 32 * 4096;
  p.gU = (float*)take(nch * 4);
  p.gW = (u16*)take(nch * 2);
  p.gQK = (u16*)take(nch * 2);
  p.gQG = (u16*)take(nch * 2);
  p.gKGt = (u16*)take(nch * 2);
  p.gGL = (float*)take((size_t)96 * 32 * 4);
  p.ropeT = (float*)take((size_t)SEQ * 8 * 2 * 4);
  p.ctr = (int*)take(256);
  p.bar = (unsigned*)take((size_t)XCD_BAR_WORDS * 4);
  static int grid_blocks = 0;
  if (!grid_blocks) {
    int dev = 0, cus = 0, per_cu = 0;
    hipGetDevice(&dev);
    hipDeviceGetAttribute(&cus, hipDeviceAttributeMultiprocessorCount, dev);
    hipOccupancyMaxActiveBlocksPerMultiprocessor(&per_cu, mega, 256, 0);
    if (per_cu < 1) per_cu = 1;
    if (per_cu > 2) per_cu = 2;
    grid_blocks = cus * per_cu;
  }
  hipMemsetAsync(p.bar, 0, (size_t)XCD_BAR_WORDS * 4, stream);
#if COOP
  int lo = 0, hi = 9;
  void* args[] = {&p, &lo, &hi};
  hipError_t e = hipLaunchCooperativeKernel((void*)mega, dim3(grid_blocks), dim3(256), args, 0, stream);
  if (e != hipSuccess) fprintf(stderr, "cooperative launch failed: %s (grid %d)\n", hipGetErrorString(e), grid_blocks);
#else
  for (int ph = 0; ph < 9; ++ph) mega<<<grid_blocks, 256, 0, stream>>>(p, ph, ph + 1);
#endif
}
```
